# Optimizing an MI355X kernel written in HIP

```python
import math
import jax
import jax.numpy as jnp
from jax import lax
import numpy as np


D_MODEL = 1024
BATCH = 4
SEQ = 8192
DEPTH = 1

GRID_W = 64
CTX_LEN = 256
S5_WIDTH = 512
S5_GROUP = 16
S5_GROUPS = S5_WIDTH // S5_GROUP
S5_STATE = 64
SGU_WIDTH = 512
SGU_GROUPS = 8
SGU_GROUP_DIM = SGU_WIDTH // SGU_GROUPS
CHUNK = 128
FFN_HIDDEN = 2816
CONV_K = 3
N_BRANCH = 2
IN_WIDTH = S5_WIDTH + 2 * SGU_WIDTH + N_BRANCH * D_MODEL
N_MOD = 6
EPS = 1e-6
DT_MIN = 1e-3
DT_MAX = 1e-1

kernel_name = 'hybrid_s5_sgu_convffn_block'


def rms_norm(x, g):
    x32 = x.astype(jnp.float32)
    y = x32 * lax.rsqrt(jnp.mean(x32 * x32, axis=-1, keepdims=True) + EPS)
    return y.astype(x.dtype) * g


def layer_norm(x, g, b):
    x32 = x.astype(jnp.float32)
    xc = x32 - jnp.mean(x32, axis=-1, keepdims=True)
    y = xc * lax.rsqrt(jnp.mean(xc * xc, axis=-1, keepdims=True) + EPS)
    return y.astype(x.dtype) * g + b


def modulate(x, g, shift, scale):
    return rms_norm(x, g) * (1 + scale) + shift


def s5_discretize(a_re, a_im, log_step, b_re, b_im):
    f32 = jnp.float32
    a_re = a_re.astype(f32)
    a_im = a_im.astype(f32)
    dt = jnp.exp(log_step.astype(f32))[:, None]
    mag = jnp.exp(a_re * dt)
    ab_re = mag * jnp.cos(a_im * dt)
    ab_im = mag * jnp.sin(a_im * dt)
    p = ab_re - 1.0
    q = ab_im
    den = a_re * a_re + a_im * a_im
    k_re = ((p * a_re + q * a_im) / den)[..., None]
    k_im = ((q * a_re - p * a_im) / den)[..., None]
    b_re = b_re.astype(f32)
    b_im = b_im.astype(f32)
    bb_re = k_re * b_re - k_im * b_im
    bb_im = k_re * b_im + k_im * b_re
    return ab_re, ab_im, bb_re, bb_im


def _linear_recurrence_combine(e1, e2):
    a1r, a1i, b1r, b1i = e1
    a2r, a2i, b2r, b2i = e2
    return (a2r * a1r - a2i * a1i,
            a2r * a1i + a2i * a1r,
            a2r * b1r - a2i * b1i + b2r,
            a2r * b1i + a2i * b1r + b2i)


def s5_scan(u, ab_re, ab_im, bb_re, bb_im, s0=None):
    bsz, length, _ = u.shape
    ug = u.astype(jnp.float32).reshape(bsz, length, S5_GROUPS, S5_GROUP)
    bu_re = jnp.einsum('blgh,gnh->blgn', ug, bb_re)
    bu_im = jnp.einsum('blgh,gnh->blgn', ug, bb_im)
    if s0 is not None:
        s0_re, s0_im = s0
        bu_re = bu_re.at[:, 0].add(ab_re * s0_re - ab_im * s0_im)
        bu_im = bu_im.at[:, 0].add(ab_re * s0_im + ab_im * s0_re)
    a_re = jnp.broadcast_to(ab_re, (1, length) + ab_re.shape)
    a_im = jnp.broadcast_to(ab_im, (1, length) + ab_im.shape)
    _, _, h_re, h_im = lax.associative_scan(
        _linear_recurrence_combine, (a_re, a_im, bu_re, bu_im), axis=1)
    return h_re, h_im


def s5_readout(h_re, h_im, c_re, c_im):
    y = (jnp.einsum('blgn,ghn->blgh', h_re, c_re.astype(jnp.float32))
         - jnp.einsum('blgn,ghn->blgh', h_im, c_im.astype(jnp.float32)))
    return y.reshape(y.shape[0], y.shape[1], S5_WIDTH)


def s5_glu(y, w, b):
    y = jax.nn.gelu(y)
    return y * jax.nn.sigmoid(y @ w + b)


def s5_mixer(u, u_ctx, a_re, a_im, log_step, b_re, b_im, c_re, c_im, d_skip, w_glu, b_glu, with_ctx_out):
    f32 = jnp.float32
    y = u.astype(f32) * d_skip.astype(f32)
    y_ctx = u_ctx.astype(f32) * d_skip.astype(f32) if with_ctx_out else None
    for direction in range(2):
        ab_re, ab_im, bb_re, bb_im = s5_discretize(
            a_re[direction], a_im[direction], log_step[direction], b_re[direction], b_im[direction])
        orient = (lambda t: jnp.flip(t, axis=1)) if direction == 1 else (lambda t: t)
        hc_re, hc_im = s5_scan(orient(u_ctx), ab_re, ab_im, bb_re, bb_im)
        h_re, h_im = s5_scan(orient(u), ab_re, ab_im, bb_re, bb_im,
                             s0=(hc_re[:, -1], hc_im[:, -1]))
        y = y + orient(s5_readout(h_re, h_im, c_re[direction], c_im[direction]))
        if with_ctx_out:
            y_ctx = y_ctx + orient(s5_readout(hc_re, hc_im, c_re[direction], c_im[direction]))
    y = s5_glu(y.astype(u.dtype), w_glu, b_glu)
    if with_ctx_out:
        y_ctx = s5_glu(y_ctx.astype(u.dtype), w_glu, b_glu)
    return y, y_ctx


def sgu_mixer(z, ln_g, ln_b, w_sp, b_sp):
    u, v = jnp.split(z, 2, axis=-1)
    v = layer_norm(v, ln_g, ln_b)
    bsz, length, _ = v.shape
    v = v.reshape(bsz, length // CHUNK, CHUNK, SGU_GROUPS, SGU_GROUP_DIM)
    s = jnp.einsum('bcpgd,gqp->bcqgd', v, w_sp) + jnp.transpose(b_sp)[None, None, :, :, None]
    return u * s.reshape(bsz, length, SGU_WIDTH)


def merge_branches(y_a, y_b, gate_logits, w_proj_a, w_proj_b, b_gate, w_out):
    g_a, g_b = jnp.split(jax.nn.sigmoid(gate_logits + b_gate), N_BRANCH, axis=-1)
    return (g_a * (y_a @ w_proj_a) + g_b * (y_b @ w_proj_b)) @ w_out


def depthwise_conv_grid(u, w, b, rows, cols):
    bsz, _, ch = u.shape
    y = lax.conv_general_dilated(
        u.reshape(bsz, rows, cols, ch), w[:, :, None, :], (1, 1), 'SAME',
        dimension_numbers=('NHWC', 'HWIO', 'NHWC'), feature_group_count=ch)
    return y.reshape(bsz, rows * cols, ch) + b


def conv_ffn(h, w_up, conv_w, conv_b, w_down, rows, cols):
    up = depthwise_conv_grid(h @ w_up, conv_w, conv_b, rows, cols)
    gate, val = jnp.split(up, 2, axis=-1)
    return (jax.nn.silu(gate) * val) @ w_down


def trunk_layer(x, xc, c_silu, cc_silu, rows, w_ada, b_ada, g_mix, w_in,
                s5_a_re, s5_a_im, s5_log_step, s5_b_re, s5_b_im, s5_c_re, s5_c_im,
                s5_d, s5_w_glu, s5_b_glu, sgu_ln_g, sgu_ln_b, sgu_w, sgu_b,
                w_proj_a, w_proj_b, b_gate, w_out, g_ffn, w_up, conv_w, conv_b, w_down,
                update_ctx):
    mod = c_silu @ w_ada + b_ada
    sh1, sc1, ga1, sh2, sc2, ga2 = jnp.split(mod[:, None, :], N_MOD, axis=-1)
    mod_c = cc_silu @ w_ada + b_ada
    sh1c, sc1c, ga1c, sh2c, sc2c, ga2c = jnp.split(mod_c, N_MOD, axis=-1)

    h = modulate(x, g_mix, sh1, sc1)
    hc = modulate(xc, g_mix, sh1c, sc1c)
    proj = h @ w_in
    u_a = proj[..., :S5_WIDTH]
    z_b = jax.nn.gelu(proj[..., S5_WIDTH:S5_WIDTH + 2 * SGU_WIDTH])
    gate_logits = proj[..., S5_WIDTH + 2 * SGU_WIDTH:]
    proj_c = hc @ (w_in if update_ctx else w_in[:, :S5_WIDTH])
    u_ac = proj_c[..., :S5_WIDTH]
    y_a, y_ac = s5_mixer(u_a, u_ac, s5_a_re, s5_a_im, s5_log_step, s5_b_re, s5_b_im,
                         s5_c_re, s5_c_im, s5_d, s5_w_glu, s5_b_glu, update_ctx)
    y_b = sgu_mixer(z_b, sgu_ln_g, sgu_ln_b, sgu_w, sgu_b)
    x = x + ga1 * merge_branches(y_a, y_b, gate_logits, w_proj_a, w_proj_b, b_gate, w_out)

    h2 = modulate(x, g_ffn, sh2, sc2)
    x = x + ga2 * conv_ffn(h2, w_up, conv_w, conv_b, w_down, rows, GRID_W)

    if update_ctx:
        z_bc = jax.nn.gelu(proj_c[..., S5_WIDTH:S5_WIDTH + 2 * SGU_WIDTH])
        gate_c = proj_c[..., S5_WIDTH + 2 * SGU_WIDTH:]
        y_bc = sgu_mixer(z_bc, sgu_ln_g, sgu_ln_b, sgu_w, sgu_b)
        xc = xc + ga1c * merge_branches(y_ac, y_bc, gate_c, w_proj_a, w_proj_b, b_gate, w_out)
        h2c = modulate(xc, g_ffn, sh2c, sc2c)
        mid = CONV_K // 2
        xc = xc + ga2c * conv_ffn(h2c, w_up, conv_w[mid:mid + 1], conv_b, w_down, 1, xc.shape[1])
    else:
        xc = None
    return x, xc


def setup_inputs(seed: int = 0) -> dict:
    key = jax.random.key(seed)
    ks = jax.random.split(key, 40)
    f32 = jnp.float32
    D, L = D_MODEL, DEPTH
    G, N, H = S5_GROUPS, S5_STATE, S5_GROUP
    F2 = 2 * FFN_HIDDEN

    def nrm(k, shape, scale):
        return jax.random.normal(k, shape, f32) * scale

    n_idx = jnp.arange(N, dtype=f32)
    return {
        'x': nrm(ks[0], (BATCH, SEQ, D), 1.0),
        'c': nrm(ks[1], (BATCH, D), 1.0),
        'ctx': nrm(ks[2], (BATCH, CTX_LEN, D), 1.0),
        'c_ctx': nrm(ks[3], (D,), 1.0),
        'w_ada': nrm(ks[4], (L, D, N_MOD * D), 0.5 * D ** -0.5),
        'b_ada': nrm(ks[5], (L, N_MOD * D), 0.02),
        'g_mix': 1.0 + nrm(ks[6], (L, D), 0.02),
        'w_in': nrm(ks[7], (L, D, IN_WIDTH), D ** -0.5),
        's5_a_re': -0.5 + nrm(ks[8], (L, 2, G, N), 0.01),
        's5_a_im': math.pi * n_idx + nrm(ks[9], (L, 2, G, N), 0.01),
        's5_log_step': jax.random.uniform(ks[10], (L, 2, G), f32, math.log(DT_MIN), math.log(DT_MAX)),
        's5_b_re': nrm(ks[11], (L, 2, G, N, H), (2 * H) ** -0.5),
        's5_b_im': nrm(ks[12], (L, 2, G, N, H), (2 * H) ** -0.5),
        's5_c_re': nrm(ks[13], (L, 2, G, H, N), N ** -0.5),
        's5_c_im': nrm(ks[14], (L, 2, G, H, N), N ** -0.5),
        's5_d': nrm(ks[15], (L, S5_WIDTH), 1.0),
        's5_w_glu': nrm(ks[16], (L, S5_WIDTH, S5_WIDTH), S5_WIDTH ** -0.5),
        's5_b_glu': nrm(ks[17], (L, S5_WIDTH), 0.02),
        'sgu_ln_g': 1.0 + nrm(ks[18], (L, SGU_WIDTH), 0.02),
        'sgu_ln_b': nrm(ks[19], (L, SGU_WIDTH), 0.02),
        'sgu_w': nrm(ks[20], (L, SGU_GROUPS, CHUNK, CHUNK), CHUNK ** -0.5),
        'sgu_b': 1.0 + nrm(ks[21], (L, SGU_GROUPS, CHUNK), 0.1),
        'w_proj_a': nrm(ks[22], (L, S5_WIDTH, D), S5_WIDTH ** -0.5),
        'w_proj_b': nrm(ks[23], (L, SGU_WIDTH, D), SGU_WIDTH ** -0.5),
        'b_gate': nrm(ks[24], (L, N_BRANCH * D), 0.02),
        'w_out': nrm(ks[25], (L, D, D), D ** -0.5),
        'g_ffn': 1.0 + nrm(ks[26], (L, D), 0.02),
        'w_up': nrm(ks[27], (L, D, F2), D ** -0.5),
        'conv_w': nrm(ks[28], (L, CONV_K, CONV_K, F2), 1.0 / CONV_K),
        'conv_b': nrm(ks[29], (L, F2), 0.02),
        'w_down': nrm(ks[30], (L, FFN_HIDDEN, D), FFN_HIDDEN ** -0.5),
        'g_final': 1.0 + nrm(ks[31], (D,), 0.02),
    }


def reference(x, c, ctx, c_ctx, w_ada, b_ada, g_mix, w_in, s5_a_re, s5_a_im, s5_log_step,
              s5_b_re, s5_b_im, s5_c_re, s5_c_im, s5_d, s5_w_glu, s5_b_glu,
              sgu_ln_g, sgu_ln_b, sgu_w, sgu_b, w_proj_a, w_proj_b, b_gate, w_out,
              g_ffn, w_up, conv_w, conv_b, w_down, g_final):
    rows = x.shape[1] // GRID_W
    c_silu = jax.nn.silu(c)
    cc_silu = jax.nn.silu(c_ctx)
    xc = ctx
    for i in range(DEPTH):
        x, xc = trunk_layer(
            x, xc, c_silu, cc_silu, rows, w_ada[i], b_ada[i], g_mix[i], w_in[i],
            s5_a_re[i], s5_a_im[i], s5_log_step[i], s5_b_re[i], s5_b_im[i], s5_c_re[i], s5_c_im[i],
            s5_d[i], s5_w_glu[i], s5_b_glu[i], sgu_ln_g[i], sgu_ln_b[i], sgu_w[i], sgu_b[i],
            w_proj_a[i], w_proj_b[i], b_gate[i], w_out[i], g_ffn[i], w_up[i], conv_w[i], conv_b[i],
            w_down[i], i + 1 < DEPTH)
    return rms_norm(x, g_final)
```

```cpp
#include <hip/hip_runtime.h>
#include <hip/hip_cooperative_groups.h>
#include <cstdio>
#include <cstdint>
namespace cg = cooperative_groups;
namespace pg8 {
#define PG8_LAS __attribute__((address_space(3)))
typedef unsigned short bf16_t;
typedef short bf16x8 __attribute__((ext_vector_type(8)));
typedef float f32x4 __attribute__((ext_vector_type(4)));
typedef unsigned u32x4 __attribute__((ext_vector_type(4)));
constexpr int BM = 256, BK = 64, HALF = 128, HTB = HALF * BK * 2  , STAGE_BYTES = 8 * HTB, NXCD = 8, WGM = 8;

__host__ __device__ __forceinline__ int lds_byte(int r, int c) { const int st = (r >> 4) * 2 + (c >> 5), rr = r & 15, cc = c & 31, ob = rr * 64 + cc * 2; return st * 1024 + (ob ^ (((ob >> 9) & 1) << 5)); }
__host__ __device__ __forceinline__ void stage_rc(int b, int& R, int& C) { const int st = b / 1024, sb = b % 1024, swz = sb ^ (((sb >> 9) & 1) << 5); R = (st >> 1) * 16 + swz / 64; C = (st & 1) * 32 + (swz % 64) / 2; }
__host__ __device__ __forceinline__ int perm32(int rho) { const int n = rho >> 4, i = rho & 15; return 8 * (i >> 2) + 4 * n + (i & 3); }

struct Unit { int pm, pn; };
struct Gemm { const bf16_t* A; const bf16_t* Bt; int M, N, K; };

struct StaticOrder {
    int nM, nN, nwg, G, c;
    __host__ __device__ void init(int M, int N, int G_, int c_) { nM = M / BM; nN = N / BM; nwg = nM * nN; G = G_; c = c_; }
    __host__ __device__ bool next(int i, Unit& u) const {
        const long L = (long)i * G + c; if (L >= nwg) return false;
        int wgid = (int)L; { const int q = nwg / NXCD, r = nwg % NXCD, xcd = wgid % NXCD, off = wgid / NXCD; wgid = (xcd < r ? xcd * (q + 1) : r * (q + 1) + (xcd - r) * q) + off; }
        const int nig = WGM * nN, gid = wgid / nig, fm = gid * WGM, gsz = (nM - fm) < WGM ? (nM - fm) : WGM;
        u.pm = fm + ((wgid % nig) % gsz); u.pn = (wgid % nig) / gsz; return true;
    }
    __device__ __forceinline__ void a_ready(const Unit&) const {}
    __device__ __forceinline__ void done(const Unit&) const {}
};

__device__ __forceinline__ unsigned cvt_pk_bf16(float lo, float hi) { unsigned r; asm volatile("v_cvt_pk_bf16_f32 %0, %1, %2" : "=v"(r) : "v"(lo), "v"(hi)); return r; }
template <class Epi, class Sched, bool ALIGN_EPI = false, bool SP2 = false>
__device__ __forceinline__ void gemm_phase(PG8_LAS unsigned char* lds, const Gemm g, const Sched& S, const Epi& E) {
    const int tid = threadIdx.x, wid = __builtin_amdgcn_readfirstlane(tid >> 6), lane = tid & 63, wr = wid >> 2, wc = wid & 3, fr = lane & 15, fq = lane >> 4;
    const int K = g.K, nt = K / BK;
    unsigned voffA[2], voffB[2];
#pragma unroll
    for (int i = 0; i < 2; ++i) { int R, C; stage_rc(tid * 16 + i * 8192, R, C); const int Rb = Epi::PERM ? ((R & ~31) + perm32(R & 31)) : R;
        voffA[i] = (unsigned)(R * K + C) * 2u; voffB[i] = (unsigned)(Rb * K + C) * 2u; }
    const size_t kstep = (size_t)(BK * 2);
    const size_t hstep = (size_t)HALF * K * 2;
    const size_t tstep = 2 * hstep;
    const unsigned ldsw = (unsigned)wid * 1024u;
    const int aoff = lds_byte(wr * 64 + fr, fq * 8), boff = lds_byte(wc * 32 + fr, fq * 8);
#define PG8_SA(b, h) (((b) * 2 + (h)) * HTB)
#define PG8_SB(b, h) ((4 + (b) * 2 + (h)) * HTB)
#define PG8_STAGE(bufoff, gbase, voff) do { _Pragma("unroll") for (int _i = 0; _i < 2; ++_i) \
        __builtin_amdgcn_global_load_lds((const unsigned*)((const char*)(gbase) + (voff)[_i]), (PG8_LAS unsigned*)(lds + (bufoff) + ldsw + _i * 8192), 16, 0, 0); } while (0)
#define PG8_LDA(dst, b, h) do { _Pragma("unroll") for (int m = 0; m < 4; ++m) _Pragma("unroll") for (int k = 0; k < 2; ++k) dst[m][k] = *(const PG8_LAS bf16x8*)(lds + PG8_SA(b, h) + aoff + m * 2048 + k * 1024); } while (0)
#define PG8_LDB(dst, b, h) do { _Pragma("unroll") for (int n = 0; n < 2; ++n) _Pragma("unroll") for (int k = 0; k < 2; ++k) dst[n][k] = *(const PG8_LAS bf16x8*)(lds + PG8_SB(b, h) + boff + n * 2048 + k * 1024); } while (0)
#define PG8_MMA(ai, bj, At, Bt) do { __builtin_amdgcn_s_setprio(1); _Pragma("unroll") for (int m = 0; m < 4; ++m) _Pragma("unroll") for (int n = 0; n < 2; ++n) _Pragma("unroll") for (int k = 0; k < 2; ++k) \
        acc[ai][bj][m][n] = __builtin_amdgcn_mfma_f32_16x16x32_bf16(Bt[n][k], At[m][k], acc[ai][bj][m][n], 0, 0, 0); __builtin_amdgcn_s_setprio(0); } while (0)
#define PG8_WAIT_V(n) asm volatile("s_waitcnt vmcnt(" #n ")" ::: "memory")
#define PG8_WAIT_L(n) asm volatile("s_waitcnt lgkmcnt(" #n ")" ::: "memory")
#define PG8_BAR __builtin_amdgcn_s_barrier()
#define PG8_SCHED __builtin_amdgcn_sched_barrier(0)
    Unit cur, nxt; int ui = 0;
    if (!S.next(0, cur)) return;
    f32x4 acc[2][2][4][2];
#pragma unroll
    for (int a = 0; a < 2; ++a)
#pragma unroll
        for (int b = 0; b < 2; ++b)
#pragma unroll
            for (int m = 0; m < 4; ++m)
#pragma unroll
                for (int n = 0; n < 2; ++n) acc[a][b][m][n] = (f32x4){0.f, 0.f, 0.f, 0.f};
    bf16x8 At[4][2], B0[2][2], B1[2][2];
    const char* cA = (const char*)g.A + (size_t)cur.pm * tstep; const char* cB = (const char*)g.Bt + (size_t)cur.pn * tstep;
    S.a_ready(cur);
    if constexpr (SP2) {
        PG8_STAGE(PG8_SB(0, 0), cB, voffB); PG8_STAGE(PG8_SB(0, 1), cB + hstep, voffB); PG8_STAGE(PG8_SA(0, 0), cA, voffA); PG8_STAGE(PG8_SA(0, 1), cA + hstep, voffA);
        if (wr == 1) PG8_BAR;
        PG8_WAIT_V(2); PG8_BAR;
        PG8_STAGE(PG8_SB(1, 0), cB + kstep, voffB); PG8_STAGE(PG8_SA(1, 0), cA + kstep, voffA); PG8_STAGE(PG8_SB(1, 1), cB + hstep + kstep, voffB);
        PG8_WAIT_V(6); PG8_BAR;
    } else {
        PG8_STAGE(PG8_SB(0, 0), cB, voffB); PG8_STAGE(PG8_SA(0, 0), cA, voffA); PG8_STAGE(PG8_SB(0, 1), cB + hstep, voffB); PG8_STAGE(PG8_SA(0, 1), cA + hstep, voffA);
        if (wr == 1) PG8_BAR;
        PG8_WAIT_V(4); PG8_BAR;
        PG8_STAGE(PG8_SB(1, 0), cB + kstep, voffB); PG8_STAGE(PG8_SA(1, 0), cA + kstep, voffA); PG8_STAGE(PG8_SB(1, 1), cB + hstep + kstep, voffB);
        PG8_WAIT_V(6); PG8_BAR;
    }
    for (;;) {
        const bool has_next = S.next(ui + 1, nxt);
        const char* nA = has_next ? (const char*)g.A + (size_t)nxt.pm * tstep : cA; const char* nB = has_next ? (const char*)g.Bt + (size_t)nxt.pn * tstep : cB;
        for (int t = 0; t < nt; t += 2) {
            const bool last = (t == nt - 2);
            const char* a1 = cA + (size_t)(t + 1) * kstep;
            const char* a2 = last ? nA : cA + (size_t)(t + 2) * kstep; const char* b2 = last ? nB : cB + (size_t)(t + 2) * kstep;
            const char* a3 = a2 + kstep; const char* b3 = b2 + kstep;
            if (last && has_next) S.a_ready(nxt);
            if constexpr (SP2) {
            PG8_LDB(B0, 0, 0); PG8_LDB(B1, 0, 1); PG8_SCHED; PG8_LDA(At, 0, 0); PG8_STAGE(PG8_SA(1, 1), a1 + hstep, voffA);
            PG8_WAIT_V(8); PG8_WAIT_L(0); PG8_BAR; PG8_MMA(0, 0, At, B0); PG8_MMA(0, 1, At, B1); PG8_BAR; PG8_SCHED;
            PG8_LDA(At, 0, 1); PG8_STAGE(PG8_SB(0, 0), b2, voffB); PG8_STAGE(PG8_SB(0, 1), b2 + hstep, voffB); PG8_STAGE(PG8_SA(0, 0), a2, voffA);
            PG8_WAIT_V(8); PG8_WAIT_L(0); PG8_BAR; PG8_MMA(1, 0, At, B0); PG8_MMA(1, 1, At, B1); PG8_BAR; PG8_SCHED;
            PG8_LDB(B0, 1, 0); PG8_LDB(B1, 1, 1); PG8_SCHED; PG8_LDA(At, 1, 0); PG8_STAGE(PG8_SA(0, 1), a2 + hstep, voffA);
            PG8_WAIT_V(8); PG8_WAIT_L(0); PG8_BAR; PG8_MMA(0, 0, At, B0); PG8_MMA(0, 1, At, B1); PG8_BAR; PG8_SCHED;
            PG8_LDA(At, 1, 1); PG8_STAGE(PG8_SB(1, 0), b3, voffB); PG8_STAGE(PG8_SB(1, 1), b3 + hstep, voffB); PG8_STAGE(PG8_SA(1, 0), a3, voffA);
            PG8_WAIT_V(8); PG8_WAIT_L(0); PG8_BAR; PG8_MMA(1, 0, At, B0); PG8_MMA(1, 1, At, B1); PG8_BAR; PG8_SCHED;
            } else {
            PG8_LDB(B0, 0, 0); PG8_SCHED; PG8_LDA(At, 0, 0); PG8_STAGE(PG8_SA(1, 1), a1 + hstep, voffA);
            PG8_WAIT_L(8); PG8_BAR; PG8_WAIT_L(0); PG8_MMA(0, 0, At, B0); PG8_BAR; PG8_SCHED;
            PG8_LDB(B1, 0, 1); PG8_STAGE(PG8_SB(0, 0), b2, voffB);
            PG8_BAR; PG8_WAIT_L(0); PG8_MMA(0, 1, At, B1); PG8_BAR;
            PG8_LDA(At, 0, 1); PG8_STAGE(PG8_SA(0, 0), a2, voffA);
            PG8_BAR; PG8_WAIT_L(0); PG8_MMA(1, 0, At, B0); PG8_BAR; PG8_SCHED;
            PG8_STAGE(PG8_SB(0, 1), b2 + hstep, voffB);
            PG8_WAIT_V(6); PG8_BAR; PG8_MMA(1, 1, At, B1); PG8_BAR;
            PG8_LDB(B0, 1, 0); PG8_SCHED; PG8_LDA(At, 1, 0); PG8_STAGE(PG8_SA(0, 1), a2 + hstep, voffA);
            PG8_WAIT_L(8); PG8_BAR; PG8_WAIT_L(0); PG8_MMA(0, 0, At, B0); PG8_BAR; PG8_SCHED;
            PG8_LDB(B1, 1, 1); PG8_STAGE(PG8_SB(1, 0), b3, voffB);
            PG8_BAR; PG8_WAIT_L(0); PG8_MMA(0, 1, At, B1); PG8_BAR;
            PG8_LDA(At, 1, 1); PG8_STAGE(PG8_SA(1, 0), a3, voffA);
            PG8_BAR; PG8_WAIT_L(0); PG8_MMA(1, 0, At, B0); PG8_BAR; PG8_SCHED;
            PG8_STAGE(PG8_SB(1, 1), b3 + hstep, voffB);
            PG8_WAIT_V(6); PG8_BAR; PG8_MMA(1, 1, At, B1); PG8_BAR;
            }
        }
        if constexpr (ALIGN_EPI) { if (wr == 0) PG8_BAR; }
        if constexpr (!Epi::AFTER_DRAIN) { E(acc, cur, wr, wc, fr, fq); S.done(cur); }
        if (!has_next) break;
#pragma unroll
        for (int a = 0; a < 2; ++a)
#pragma unroll
            for (int b = 0; b < 2; ++b)
#pragma unroll
                for (int m = 0; m < 4; ++m)
#pragma unroll
                    for (int n = 0; n < 2; ++n) acc[a][b][m][n] = (f32x4){0.f, 0.f, 0.f, 0.f};
        cur = nxt; cA = nA; cB = nB; ++ui;
        if constexpr (ALIGN_EPI) { if (wr == 1) PG8_BAR; }
    }
    PG8_WAIT_V(0);
    if constexpr (!ALIGN_EPI) { if (wr == 0) PG8_BAR; }
    PG8_BAR;
    if constexpr (Epi::AFTER_DRAIN) { E.fused(acc, cur, wr, wc, fr, fq, lds, wid, lane); S.done(cur); }
#undef PG8_SA
#undef PG8_SB
#undef PG8_STAGE
#undef PG8_LDA
#undef PG8_LDB
#undef PG8_MMA
#undef PG8_WAIT_V
#undef PG8_WAIT_L
#undef PG8_BAR
#undef PG8_SCHED
}
}

#define LAS __attribute__((address_space(3)))
using pg8::bf16_t; using pg8::bf16x8; using pg8::f32x4; using pg8::u32x4; using pg8::Unit;
typedef unsigned u32x2 __attribute__((ext_vector_type(2)));
typedef float f32x2_t __attribute__((ext_vector_type(2)));
typedef __bf16 bf16x2_t __attribute__((ext_vector_type(2)));
__device__ __forceinline__ unsigned cvt_pk_bf16(float lo, float hi) { f32x2_t v = {lo, hi}; bf16x2_t b = __builtin_convertvector(v, bf16x2_t); return __builtin_bit_cast(unsigned, b); }

constexpr int DM = 1024, NB = 4, SEQ = 8192, MTOK = NB * SEQ, CTXL = 256, MCTX = NB * CTXL, MALL = MTOK + MCTX;
constexpr int LTOT = CTXL + SEQ, NCH = LTOT / 16, NMOD = 6 * DM;
constexpr int FFH = 2816, F2 = 2 * FFH, J1 = 1536, J2 = 1280;
constexpr int NTHR = 512, LDS_BYTES = 147456;
constexpr float EPS = 1e-6f;

constexpr size_t MiB = 1u << 20;
constexpr size_t WS_WUP1 = 0, WS_WUP2 = 6 * MiB, WS_WDN1 = 11 * MiB, WS_WDN2 = 14 * MiB;
constexpr size_t WS_WIN = 17 * MiB, WS_WGLU = 24 * MiB, WS_WPA = 24 * MiB + 512 * 1024, WS_WPB = 25 * MiB + 512 * 1024, WS_WOUT = 26 * MiB + 512 * 1024;
constexpr size_t WS_PFRAG = 29 * MiB, WS_QFRAG = 33 * MiB, WS_TFRAG = 37 * MiB, WS_SGUW = 38 * MiB, WS_MOD = 38 * MiB + 512 * 1024;
constexpr size_t WS_HBUF = 40 * MiB, WS_ZB = 106 * MiB, WS_UG = 170 * MiB, WS_GATES = 203 * MiB, WS_SBUF = 331 * MiB, WS_HPREV = 397 * MiB,
                 WS_YB = 430 * MiB, WS_GY = 462 * MiB, WS_YA = 170 * MiB, WS_TMP = 40 * MiB, WS_MBUF = 331 * MiB;
constexpr size_t WS_UPB = 106 * MiB, WS_ACT1 = 298 * MiB, WS_ACT2 = 394 * MiB, WS_END = 474 * MiB;

__device__ __forceinline__ float bflo(unsigned w) { return __builtin_bit_cast(float, w << 16); }
__device__ __forceinline__ float bfhi(unsigned w) { return __builtin_bit_cast(float, w & 0xffff0000u); }
__device__ __forceinline__ float bf2f(bf16_t h) { return __builtin_bit_cast(float, ((unsigned)h) << 16); }
__device__ __forceinline__ bf16_t f2bf(float f) { unsigned u = __builtin_bit_cast(unsigned, f); return (bf16_t)((u + 0x7fffu + ((u >> 16) & 1u)) >> 16); }
__device__ __forceinline__ float sigm(float v) { return __builtin_amdgcn_rcpf(1.f + __expf(-v)); }
__device__ __forceinline__ float gelu_t(float x) { const float t = 1.5957691216057308f * (x + 0.044715f * x * x * x); return x * sigm(t); }
__device__ __forceinline__ float wave_sum(float v) {
#pragma unroll
    for (int o = 1; o < 64; o <<= 1) v += __shfl_xor(v, o);
    return v;
}
__device__ __forceinline__ u32x4 pack8(f32x4 a, f32x4 b) { u32x4 w; w.x = cvt_pk_bf16(a[0], a[1]); w.y = cvt_pk_bf16(a[2], a[3]); w.z = cvt_pk_bf16(b[0], b[1]); w.w = cvt_pk_bf16(b[2], b[3]); return w; }
__device__ __forceinline__ void unpack8(u32x4 w, f32x4& a, f32x4& b) { a = (f32x4){bflo(w.x), bfhi(w.x), bflo(w.y), bfhi(w.y)}; b = (f32x4){bflo(w.z), bfhi(w.z), bflo(w.w), bfhi(w.w)}; }
#define LDS_WAIT() asm volatile("s_waitcnt lgkmcnt(0)" ::: "memory")
#define MFMA16(a, b, c) __builtin_amdgcn_mfma_f32_16x16x32_bf16((a), (b), (c), 0, 0, 0)

struct OrderX {
    int nM, nN, nwg, G, c, nExtra, xpm0, xnN;
    __device__ void init(int M, int N, int G_, int c_, int nExtra_ = 0, int xpm0_ = 0, int xnN_ = 1) { nM = M / 256; nN = N / 256; nwg = nM * nN; G = G_; c = c_; nExtra = nExtra_; xpm0 = xpm0_; xnN = xnN_; }
    __device__ bool next(int i, Unit& u) const {
        const long L = (long)i * G + c; if (L >= nwg + nExtra) return false;
        if (L >= nwg) { const int e = (int)L - nwg; u.pm = xpm0 + e / xnN; u.pn = e % xnN; return true; }
        int wgid = (int)L; { const int q = nwg / 8, r = nwg % 8, xcd = wgid % 8, off = wgid / 8; wgid = (xcd < r ? xcd * (q + 1) : r * (q + 1) + (xcd - r) * q) + off; }
        const int nig = 8 * nN, gid = wgid / nig, fm = gid * 8, gsz = (nM - fm) < 8 ? (nM - fm) : 8;
        u.pm = fm + ((wgid % nig) % gsz); u.pn = (wgid % nig) / gsz; return true;
    }
    __device__ __forceinline__ void a_ready(const Unit&) const {}
    __device__ __forceinline__ void done(const Unit&) const {}
};

#define EPI_HEAD const int row0 = u.pm * 256 + wr * 64 + fr; const int col0 = u.pn * 256 + wc * 32 + 8 * fq;
#define EPI_LOOP _Pragma("unroll") for (int ai = 0; ai < 2; ++ai) _Pragma("unroll") for (int m = 0; m < 4; ++m) _Pragma("unroll") for (int bj = 0; bj < 2; ++bj)

struct EpiIn {
    static constexpr bool PERM = true, AFTER_DRAIN = false;
    bf16_t* ug; bf16_t* zb; bf16_t* gates; const float* bgate;
    __device__ __forceinline__ void operator()(const f32x4 (&acc)[2][2][4][2], const Unit& u, int wr, int wc, int fr, int fq) const {
        EPI_HEAD
        if (u.pn < 2) {
            EPI_LOOP { const int row = row0 + ai * 128 + m * 16, c = col0 + bj * 128;
                int b, pos; if (row < MTOK) { b = row >> 13; pos = CTXL + (row & (SEQ - 1)); } else { const int rr = row - MTOK; b = rr >> 8; pos = rr & (CTXL - 1); }
                const int g = c >> 4, hh = c & 15;
                *(u32x4*)(ug + ((size_t)(b * 32 + g) * LTOT + pos) * 16 + hh) = pack8(acc[ai][bj][m][0], acc[ai][bj][m][1]); }
        } else if (u.pn < 6) {
            EPI_LOOP { const int row = row0 + ai * 128 + m * 16, c = col0 + bj * 128 - 512;
                f32x4 v0 = acc[ai][bj][m][0], v1 = acc[ai][bj][m][1];
#pragma unroll
                for (int e = 0; e < 4; ++e) { v0[e] = gelu_t(v0[e]); v1[e] = gelu_t(v1[e]); }
                *(u32x4*)(zb + (size_t)row * 1024 + c) = pack8(v0, v1); }
        } else {
            f32x4 bv[2][2];
#pragma unroll
            for (int bj = 0; bj < 2; ++bj) { bv[bj][0] = *(const f32x4*)(bgate + col0 + bj * 128 - 1536); bv[bj][1] = *(const f32x4*)(bgate + col0 + bj * 128 - 1536 + 4); }
            EPI_LOOP { const int row = row0 + ai * 128 + m * 16, c = col0 + bj * 128 - 1536;
                f32x4 v0 = acc[ai][bj][m][0] + bv[bj][0], v1 = acc[ai][bj][m][1] + bv[bj][1];
#ifndef DBG_NOSIG
#pragma unroll
                for (int e = 0; e < 4; ++e) { v0[e] = sigm(v0[e]); v1[e] = sigm(v1[e]); }
#endif
                *(u32x4*)(gates + (size_t)row * 2048 + c) = pack8(v0, v1); }
        }
    }
};
struct EpiGlu {
    static constexpr bool PERM = true, AFTER_DRAIN = false;
    const bf16_t* gy; bf16_t* ya; const float* bias;
    __device__ __forceinline__ void operator()(const f32x4 (&acc)[2][2][4][2], const Unit& u, int wr, int wc, int fr, int fq) const {
        EPI_HEAD
        f32x4 bv[2][2];
#pragma unroll
        for (int bj = 0; bj < 2; ++bj) { bv[bj][0] = *(const f32x4*)(bias + col0 + bj * 128); bv[bj][1] = *(const f32x4*)(bias + col0 + bj * 128 + 4); }
        EPI_LOOP { const int row = row0 + ai * 128 + m * 16, c = col0 + bj * 128;
            f32x4 g0, g1; unpack8(*(const u32x4*)(gy + (size_t)row * 512 + c), g0, g1);
            f32x4 v0 = acc[ai][bj][m][0] + bv[bj][0], v1 = acc[ai][bj][m][1] + bv[bj][1];
#pragma unroll
            for (int e = 0; e < 4; ++e) { v0[e] = g0[e] * sigm(v0[e]); v1[e] = g1[e] * sigm(v1[e]); }
            *(u32x4*)(ya + (size_t)row * 512 + c) = pack8(v0, v1); }
    }
};
struct EpiMergeA {
    static constexpr bool PERM = true, AFTER_DRAIN = false;
    const bf16_t* gates; float* tmp;
    __device__ __forceinline__ void operator()(const f32x4 (&acc)[2][2][4][2], const Unit& u, int wr, int wc, int fr, int fq) const {
        EPI_HEAD
        EPI_LOOP { const int row = row0 + ai * 128 + m * 16, c = col0 + bj * 128;
            f32x4 g0, g1; unpack8(*(const u32x4*)(gates + (size_t)row * 2048 + c), g0, g1);
            *(f32x4*)(tmp + (size_t)row * 1024 + c) = g0 * acc[ai][bj][m][0]; *(f32x4*)(tmp + (size_t)row * 1024 + c + 4) = g1 * acc[ai][bj][m][1]; }
    }
};
struct EpiMergeB {
    static constexpr bool PERM = true, AFTER_DRAIN = false;
    const bf16_t* gates; const float* tmp; bf16_t* mb;
    __device__ __forceinline__ void operator()(const f32x4 (&acc)[2][2][4][2], const Unit& u, int wr, int wc, int fr, int fq) const {
        EPI_HEAD
        EPI_LOOP { const int row = row0 + ai * 128 + m * 16, c = col0 + bj * 128;
            f32x4 g0, g1; unpack8(*(const u32x4*)(gates + (size_t)row * 2048 + 1024 + c), g0, g1);
            const f32x4 t0 = *(const f32x4*)(tmp + (size_t)row * 1024 + c), t1 = *(const f32x4*)(tmp + (size_t)row * 1024 + c + 4);
            *(u32x4*)(mb + (size_t)row * 1024 + c) = pack8(t0 + g0 * acc[ai][bj][m][0], t1 + g1 * acc[ai][bj][m][1]); }
    }
};
struct EpiRes {
    static constexpr bool PERM = true, AFTER_DRAIN = false;
    const float* base; float* out; const float* gate;
    __device__ __forceinline__ void operator()(const f32x4 (&acc)[2][2][4][2], const Unit& u, int wr, int wc, int fr, int fq) const {
        EPI_HEAD
        const int b = (u.pm * 256) >> 13;
        f32x4 gv[2][2];
#pragma unroll
        for (int bj = 0; bj < 2; ++bj) { gv[bj][0] = *(const f32x4*)(gate + b * NMOD + col0 + bj * 128); gv[bj][1] = *(const f32x4*)(gate + b * NMOD + col0 + bj * 128 + 4); }
        EPI_LOOP { const int row = row0 + ai * 128 + m * 16, c = col0 + bj * 128;
            const f32x4 x0 = *(const f32x4*)(base + (size_t)row * 1024 + c), x1 = *(const f32x4*)(base + (size_t)row * 1024 + c + 4);
            *(f32x4*)(out + (size_t)row * 1024 + c) = x0 + gv[bj][0] * acc[ai][bj][m][0]; *(f32x4*)(out + (size_t)row * 1024 + c + 4) = x1 + gv[bj][1] * acc[ai][bj][m][1]; }
    }
};
struct EpiPlain {
    static constexpr bool PERM = true, AFTER_DRAIN = false;
    bf16_t* O; int ldc;
    __device__ __forceinline__ void operator()(const f32x4 (&acc)[2][2][4][2], const Unit& u, int wr, int wc, int fr, int fq) const {
        EPI_HEAD
        EPI_LOOP { const int row = row0 + ai * 128 + m * 16, c = col0 + bj * 128;
            *(u32x4*)(O + (size_t)row * ldc + c) = pack8(acc[ai][bj][m][0], acc[ai][bj][m][1]); }
    }
};

__device__ __forceinline__ void tr_item(const float* W, int ldw, int k0s, int n0s, bf16_t* WT, int dpitch, int k0d, int n0d, LAS float* scr, int lane) {
#pragma unroll 8
    for (int i = 0; i < 32; ++i) { const int kk = 2 * i + (lane >> 5); scr[kk * 33 + (lane & 31)] = W[(size_t)(k0s + kk) * ldw + n0s + (lane & 31)]; }
    LDS_WAIT();
    const int c = lane & 7;
#pragma unroll
    for (int j = 0; j < 4; ++j) { const int n = (lane >> 3) + 8 * j; const LAS float* s = scr + (8 * c) * 33 + n;
        u32x4 o; o.x = cvt_pk_bf16(s[0 * 33], s[1 * 33]); o.y = cvt_pk_bf16(s[2 * 33], s[3 * 33]); o.z = cvt_pk_bf16(s[4 * 33], s[5 * 33]); o.w = cvt_pk_bf16(s[6 * 33], s[7 * 33]);
        *(u32x4*)(WT + (size_t)(n0d + n) * dpitch + k0d + 8 * c) = o; }
    LDS_WAIT();
}
__device__ __forceinline__ bool tr_job(int& r, const float* W, int ldw, int ks, int ns, int nK, int nN, bf16_t* WT, int dp, int nd0, LAS float* scr, int lane) {
    const int nb = nN / 32, items = (nK / 64) * nb;
    if (r < items) { const int kb = r / nb, nbi = r % nb; tr_item(W, ldw, ks + 64 * kb, ns + 32 * nbi, WT, dp, 64 * kb, nd0 + 32 * nbi, scr, lane); return true; }
    r -= items; return false;
}

struct P0Args { const float *c, *cctx, *wada, *bada, *w_in, *w_glu, *w_pa, *w_pb, *w_out, *w_up, *w_down, *sgu_w;
                const float *a_re, *a_im, *logstep, *b_re, *b_im, *c_re, *c_im, *dskip; };

__device__ __forceinline__ void p0_gemv_item(int it, const P0Args& A, float* mod, LAS unsigned char* lds, int tid, int lane, int wave) {
    LAS float* sv = (LAS float*)(lds); LAS float* red = (LAS float*)(lds + 24576);
    for (int i = tid; i < 5 * 1024; i += NTHR) { const int r = i >> 10, k = i & 1023; const float v = r < 4 ? A.c[r * 1024 + k] : A.cctx[k]; sv[i] = v / (1.f + expf(-v)); }
    __syncthreads();
    const int n = it * 64 + lane, k0 = wave * 128;
    float a0 = 0.f, a1 = 0.f, a2 = 0.f, a3 = 0.f, a4 = 0.f;
#pragma unroll 8
    for (int kk = 0; kk < 128; ++kk) { const float w = A.wada[(size_t)(k0 + kk) * NMOD + n];
        a0 += sv[k0 + kk] * w; a1 += sv[1024 + k0 + kk] * w; a2 += sv[2048 + k0 + kk] * w; a3 += sv[3072 + k0 + kk] * w; a4 += sv[4096 + k0 + kk] * w; }
    red[(wave * 5 + 0) * 64 + lane] = a0; red[(wave * 5 + 1) * 64 + lane] = a1; red[(wave * 5 + 2) * 64 + lane] = a2; red[(wave * 5 + 3) * 64 + lane] = a3; red[(wave * 5 + 4) * 64 + lane] = a4;
    __syncthreads();
    if (tid < 320) { const int r = tid >> 6, l = tid & 63; float s = 0.f;
#pragma unroll
        for (int w = 0; w < 8; ++w) s += red[(w * 5 + r) * 64 + l];
        mod[r * NMOD + it * 64 + l] = s + A.bada[it * 64 + l]; }
    __syncthreads();
}

__device__ __forceinline__ void p0_s5_item(int dg, const P0Args& A, bf16_t* pfrag, bf16_t* qfrag, bf16_t* tfrag, LAS unsigned char* lds, int tid) {
    const int d = dg >> 5, g = dg & 31;
    LAS float* apr = (LAS float*)lds;
    LAS float* api = apr + 17 * 64;
    LAS float* bbr = api + 17 * 64;
    LAS float* bbi = bbr + 1024;
    LAS float* cr = bbi + 1024;
    LAS float* ci = cr + 1024;
    LAS float* T = ci + 1024;
    const float dt = expf(A.logstep[dg]);
    const float* are = A.a_re + dg * 64; const float* aim = A.a_im + dg * 64;
    for (int i = tid; i < 17 * 64; i += NTHR) { const int k = i >> 6, n = i & 63; const float kd = (float)k * dt; const float mag = expf(kd * are[n]); const float ang = kd * aim[n];
        apr[i] = mag * cosf(ang); api[i] = mag * sinf(ang); }
    for (int i = tid; i < 1024; i += NTHR) { cr[i] = A.c_re[dg * 1024 + i]; ci[i] = A.c_im[dg * 1024 + i]; }
    __syncthreads();
    for (int i = tid; i < 1024; i += NTHR) { const int n = i >> 4; const float ar = are[n], ai = aim[n]; const float p = apr[64 + n] - 1.f, q = api[64 + n]; const float den = ar * ar + ai * ai;
        const float kr = (p * ar + q * ai) / den, ki = (q * ar - p * ai) / den; const float br = A.b_re[dg * 1024 + i], bi = A.b_im[dg * 1024 + i];
        bbr[i] = kr * br - ki * bi; bbi[i] = kr * bi + ki * br; }
    __syncthreads();
    for (int i = tid; i < 4096; i += NTHR) { const int lag = i >> 8, ho = (i >> 4) & 15, hi = i & 15; float s = 0.f;
        for (int n = 0; n < 64; ++n) { const float c_r = cr[ho * 64 + n], c_i = ci[ho * 64 + n], p_r = apr[lag * 64 + n], p_i = api[lag * 64 + n];
            const float qr = c_r * p_r - c_i * p_i, qi = c_r * p_i + c_i * p_r; s += qr * bbr[n * 16 + hi] - qi * bbi[n * 16 + hi]; }
        if (d == 0 && lag == 0 && ho == hi) s += A.dskip[g * 16 + ho];
        T[i] = s; }
    for (int f = tid; f < 4096; f += NTHR) { const int nt = f >> 9, ks = (f >> 6) & 7, ln = f & 63; const int col = nt * 16 + (ln & 15), kg = ln >> 4; const int jtok = ks * 2 + (kg >> 1), h0 = (kg & 1) * 8;
        const int n = col & 63, im = col >> 6; const int pw = d == 0 ? 15 - jtok : jtok; const float p_r = apr[pw * 64 + n], p_i = api[pw * 64 + n];
        float v[8];
#pragma unroll
        for (int e = 0; e < 8; ++e) { const float b_r = bbr[n * 16 + h0 + e], b_i = bbi[n * 16 + h0 + e]; v[e] = im ? (p_r * b_i + p_i * b_r) : (p_r * b_r - p_i * b_i); }
        u32x4 o; o.x = cvt_pk_bf16(v[0], v[1]); o.y = cvt_pk_bf16(v[2], v[3]); o.z = cvt_pk_bf16(v[4], v[5]); o.w = cvt_pk_bf16(v[6], v[7]);
        *(u32x4*)(pfrag + ((size_t)dg * 4096 + f) * 8) = o; }
    for (int f = tid; f < 4096; f += NTHR) { const int jout = f >> 8, ks = (f >> 6) & 3, ln = f & 63; const int ho = ln & 15, kg = ln >> 4; const int pw = d == 0 ? jout + 1 : 16 - jout;
        float v[8];
#pragma unroll
        for (int e = 0; e < 8; ++e) { const int kk = ks * 32 + kg * 8 + e, n = kk & 63, im = kk >> 6; const float c_r = cr[ho * 64 + n], c_i = ci[ho * 64 + n], p_r = apr[pw * 64 + n], p_i = api[pw * 64 + n];
            v[e] = im ? -(c_r * p_i + c_i * p_r) : (c_r * p_r - c_i * p_i); }
        u32x4 o; o.x = cvt_pk_bf16(v[0], v[1]); o.y = cvt_pk_bf16(v[2], v[3]); o.z = cvt_pk_bf16(v[4], v[5]); o.w = cvt_pk_bf16(v[6], v[7]);
        *(u32x4*)(qfrag + ((size_t)dg * 4096 + f) * 8) = o; }
    __syncthreads();
    for (int f = tid; f < 1024; f += NTHR) { const int dd = f >> 6, ln = f & 63; const int ho = ln & 15, kg = ln >> 4; const int lag = d == 0 ? dd - (kg >> 1) : dd - 1 + (kg >> 1); const int hi0 = (kg & 1) * 8;
        float v[8];
#pragma unroll
        for (int e = 0; e < 8; ++e) v[e] = lag >= 0 ? T[(lag & 15) * 256 + ho * 16 + hi0 + e] : 0.f;
        u32x4 o; o.x = cvt_pk_bf16(v[0], v[1]); o.y = cvt_pk_bf16(v[2], v[3]); o.z = cvt_pk_bf16(v[4], v[5]); o.w = cvt_pk_bf16(v[6], v[7]);
        *(u32x4*)(tfrag + ((size_t)dg * 1024 + f) * 8) = o; }
    __syncthreads();
}

__device__ __forceinline__ void mod_rows(const float* xs, const float* ctx, int nrows, const float* gamma, const float* mod, int shoff, int scoff, bf16_t* out, int gw, int NGW, int lane) {
    for (int m = gw; m < nrows; m += NGW) {
        const float* xr; int mr;
        if (m < MTOK) { xr = xs + (size_t)m * DM; mr = m >> 13; } else { xr = ctx + (size_t)(m - MTOK) * DM; mr = 4; }
        f32x4 v[4]; float s = 0.f;
#pragma unroll
        for (int j = 0; j < 4; ++j) { v[j] = ((const f32x4*)xr)[lane + 64 * j]; s += (v[j][0] * v[j][0] + v[j][1] * v[j][1]) + (v[j][2] * v[j][2] + v[j][3] * v[j][3]); }
        const float rstd = rsqrtf(wave_sum(s) * (1.f / DM) + EPS);
#pragma unroll
        for (int j = 0; j < 4; ++j) { const int col = 4 * (lane + 64 * j);
            const f32x4 g4 = *(const f32x4*)(gamma + col), sc4 = *(const f32x4*)(mod + mr * NMOD + scoff + col), sh4 = *(const f32x4*)(mod + mr * NMOD + shoff + col);
            const f32x4 o = (v[j] * rstd) * g4 * (sc4 + 1.f) + sh4;
            u32x2 w; w.x = cvt_pk_bf16(o[0], o[1]); w.y = cvt_pk_bf16(o[2], o[3]);
            *(u32x2*)(out + (size_t)m * DM + col) = w; }
    }
}

__device__ __forceinline__ void mod_rows2(const float* xs, const float* ctx, int nrows, const float* gamma, const float* mod, int shoff, int scoff, bf16_t* out, int gw, int NGW, int lane) {
    for (int m = gw; m < nrows; m += NGW) {
        const float* xr; int mr;
        if (m < MTOK) { xr = xs + (size_t)m * DM; mr = m >> 13; } else { xr = ctx + (size_t)(m - MTOK) * DM; mr = 4; }
        f32x4 v[4]; float s = 0.f;
#pragma unroll
        for (int j = 0; j < 4; ++j) { v[j] = ((const f32x4*)xr)[lane + 64 * j]; s += (v[j][0] * v[j][0] + v[j][1] * v[j][1]) + (v[j][2] * v[j][2] + v[j][3] * v[j][3]); }
        const float rstd = rsqrtf(wave_sum(s) * (1.f / DM) + EPS);
#pragma unroll
        for (int j = 0; j < 4; ++j) { const int col = 4 * (lane + 64 * j);
            const f32x4 g4 = *(const f32x4*)(gamma + col), sc4 = *(const f32x4*)(mod + mr * NMOD + scoff + col), sh4 = *(const f32x4*)(mod + mr * NMOD + shoff + col);
            const f32x4 o = (v[j] * rstd) * g4 * (sc4 + 1.f) + sh4;
            u32x2 w; w.x = cvt_pk_bf16(o[0], o[1]); w.y = cvt_pk_bf16(o[2], o[3]);
            *(u32x2*)(out + (size_t)m * DM + col) = w; }
    }
}

__device__ __forceinline__ void s5ab_item(int item, LAS unsigned char* lds, const bf16_t* pfrag, const bf16_t* ug, float* S, bf16_t* hprev,
                                          const float* a_re, const float* a_im, const float* logstep, int tid, int lane, int wave) {
    const int d = item >> 7, b = (item >> 5) & 3, g = item & 31, dg = d * 32 + g;
    { const u32x4* src = (const u32x4*)(pfrag + (size_t)dg * 32768);
      for (int i = tid; i < 4096; i += NTHR) ((LAS u32x4*)lds)[i] = src[i]; }
    __syncthreads();
    const bf16_t* useq = ug + (size_t)(b * 32 + g) * LTOT * 16;
    float* Sit = S + (size_t)item * NCH * 128;
    const int kg = lane >> 4;
    for (int mt = wave; mt < NCH / 16; mt += 8) {
        const int chunk = mt * 16 + (lane & 15);
        bf16x8 act[8];
#pragma unroll
        for (int ks = 0; ks < 8; ++ks) act[ks] = *(const bf16x8*)(useq + (size_t)chunk * 256 + ks * 32 + kg * 8);
#pragma unroll 1
        for (int nt = 0; nt < 8; ++nt) { f32x4 acc = {0.f, 0.f, 0.f, 0.f};
#pragma unroll
            for (int ks = 0; ks < 8; ++ks) acc = MFMA16(*(const LAS bf16x8*)(lds + ((nt * 8 + ks) * 64 + lane) * 16), act[ks], acc);
            *(f32x4*)(Sit + (size_t)chunk * 128 + nt * 16 + kg * 4) = acc; }
    }
    __threadfence(); __syncthreads();
    LAS float* F = (LAS float*)(lds + 65536);
    const int n = tid & 63, seg = tid >> 6;
    const float dt = expf(logstep[dg]); const float ar = a_re[dg * 64 + n], ai = a_im[dg * 64 + n];
    float a16r, a16i; { const float k16 = 16.f * dt; const float mag = expf(k16 * ar); const float ang = k16 * ai; a16r = mag * cosf(ang); a16i = mag * sinf(ang); }
    const int s0 = seg * 66;
    float hr = 0.f, hi = 0.f;
    for (int s = s0; s < s0 + 66; ++s) { const int cc = d == 0 ? s : (s < 16 ? 15 - s : 543 - s);
        const float sr = Sit[(size_t)cc * 128 + n], si = Sit[(size_t)cc * 128 + 64 + n];
        const float nr = a16r * hr - a16i * hi + sr, ni = a16r * hi + a16i * hr + si; hr = nr; hi = ni; }
    F[(seg * 64 + n) * 2] = hr; F[(seg * 64 + n) * 2 + 1] = hi;
    __syncthreads();
    float Ar, Ai;
    { float p2r = a16r * a16r - a16i * a16i, p2i = 2.f * a16r * a16i; float pr = p2r, pi = p2i;
#pragma unroll
      for (int q = 0; q < 5; ++q) { const float t = pr * pr - pi * pi; pi = 2.f * pr * pi; pr = t; }
      Ar = pr * p2r - pi * p2i; Ai = pr * p2i + pi * p2r; }
    hr = 0.f; hi = 0.f;
    for (int q = 0; q < seg; ++q) { const float fr_ = F[(q * 64 + n) * 2], fi_ = F[(q * 64 + n) * 2 + 1]; const float nr = Ar * hr - Ai * hi + fr_, ni = Ar * hi + Ai * hr + fi_; hr = nr; hi = ni; }
    bf16_t* hp = hprev + (size_t)item * NCH * 128;
    for (int s = s0; s < s0 + 66; ++s) { const int cc = d == 0 ? s : (s < 16 ? 15 - s : 543 - s);
        hp[(size_t)cc * 128 + n] = f2bf(hr); hp[(size_t)cc * 128 + 64 + n] = f2bf(hi);
        const float sr = Sit[(size_t)cc * 128 + n], si = Sit[(size_t)cc * 128 + 64 + n];
        const float nr = a16r * hr - a16i * hi + sr, ni = a16r * hi + a16i * hr + si; hr = nr; hi = ni; }
    __syncthreads();
}

constexpr int VTP = 136;
__device__ __forceinline__ void sgu_item(int chunk, LAS unsigned char* lds, const bf16_t* zb, const bf16_t* sguw16, const float* sgub, const float* lng, const float* lnb, bf16_t* yb, int tid, int lane, int wave) {
    LAS bf16_t* vT = (LAS bf16_t*)lds;
    float gl[8], bl[8];
#pragma unroll
    for (int e = 0; e < 8; ++e) { gl[e] = lng[lane + 64 * e]; bl[e] = lnb[lane + 64 * e]; }
    for (int i = 0; i < 16; ++i) { const int p = wave * 16 + i; const bf16_t* zr = zb + (size_t)(chunk * 128 + p) * 1024 + 512;
        float v[8]; float s = 0.f;
#pragma unroll
        for (int e = 0; e < 8; ++e) { v[e] = bf2f(zr[lane + 64 * e]); s += v[e]; }
        const float mean = wave_sum(s) * (1.f / 512.f); float s2 = 0.f;
#pragma unroll
        for (int e = 0; e < 8; ++e) { v[e] -= mean; s2 += v[e] * v[e]; }
        const float rstd = rsqrtf(wave_sum(s2) * (1.f / 512.f) + EPS);
#pragma unroll
        for (int e = 0; e < 8; ++e) vT[(lane + 64 * e) * VTP + p] = f2bf(v[e] * rstd * gl[e] + bl[e]);
    }
    __syncthreads();
    const int gg = wave, i_ = lane & 15, kg = lane >> 4;
    bf16x8 vf[4][4];
#pragma unroll
    for (int dt = 0; dt < 4; ++dt)
#pragma unroll
        for (int ks = 0; ks < 4; ++ks) vf[dt][ks] = *(const LAS bf16x8*)(vT + (gg * 64 + dt * 16 + i_) * VTP + ks * 32 + kg * 8);
    for (int qt = 0; qt < 8; ++qt) { const int q = qt * 16 + i_;
        bf16x8 wf[4];
#pragma unroll
        for (int ks = 0; ks < 4; ++ks) wf[ks] = *(const bf16x8*)(sguw16 + ((size_t)(gg * 128 + q)) * 128 + ks * 32 + kg * 8);
        f32x4 acc[4];
#pragma unroll
        for (int dt = 0; dt < 4; ++dt) { acc[dt] = (f32x4){0.f, 0.f, 0.f, 0.f};
#pragma unroll
            for (int ks = 0; ks < 4; ++ks) acc[dt] = MFMA16(vf[dt][ks], wf[ks], acc[dt]); }
        const float bias = sgub[gg * 128 + q]; const size_t row = (size_t)chunk * 128 + q;
#pragma unroll
        for (int dt = 0; dt < 4; ++dt) { const int c = gg * 64 + dt * 16 + kg * 4; const u32x2 uz = *(const u32x2*)(zb + row * 1024 + c);
            u32x2 w; w.x = cvt_pk_bf16(bflo(uz.x) * (acc[dt][0] + bias), bfhi(uz.x) * (acc[dt][1] + bias)); w.y = cvt_pk_bf16(bflo(uz.y) * (acc[dt][2] + bias), bfhi(uz.y) * (acc[dt][3] + bias));
            *(u32x2*)(yb + row * 512 + c) = w; }
    }
    __syncthreads();
}

__device__ __forceinline__ void s5c_item(int item, LAS unsigned char* lds, const bf16_t* qfrag, const bf16_t* tfrag, const bf16_t* ug, const bf16_t* hprev, bf16_t* gy, int tid, int lane, int wave) {
    const int b = item >> 7, g = (item >> 2) & 31, quarter = item & 3;
    const bf16_t* useq = ug + (size_t)(b * 32 + g) * LTOT * 16;
    const int kg = lane >> 4;
    const int chunk = 16 + (quarter * 8 + wave) * 16 + (lane & 15);
    bf16x8 U[8];
#pragma unroll
    for (int ks = 0; ks < 8; ++ks) U[ks] = *(const bf16x8*)(useq + (size_t)chunk * 256 + ks * 32 + kg * 8);
    f32x4 acc[16];
#pragma unroll
    for (int j = 0; j < 16; ++j) acc[j] = (f32x4){0.f, 0.f, 0.f, 0.f};
#pragma unroll
    for (int d = 0; d < 2; ++d) {
        __syncthreads();
        { const u32x4* src = (const u32x4*)(qfrag + (size_t)(d * 32 + g) * 32768);
          for (int i = tid; i < 4096; i += NTHR) ((LAS u32x4*)lds)[i] = src[i];
          const u32x4* srt = (const u32x4*)(tfrag + (size_t)(d * 32 + g) * 8192);
          for (int i = tid; i < 1024; i += NTHR) ((LAS u32x4*)(lds + 65536))[i] = srt[i]; }
        const bf16_t* hp = hprev + ((size_t)((d * 4 + b) * 32 + g) * NCH + chunk) * 128;
        bf16x8 H[4];
#pragma unroll
        for (int ks = 0; ks < 4; ++ks) H[ks] = *(const bf16x8*)(hp + ks * 32 + kg * 8);
        __syncthreads();
#pragma unroll
        for (int jout = 0; jout < 16; ++jout) {
#pragma unroll
            for (int ks = 0; ks < 4; ++ks) acc[jout] = MFMA16(*(const LAS bf16x8*)(lds + ((jout * 4 + ks) * 64 + lane) * 16), H[ks], acc[jout]);
            if (d == 0) {
#pragma unroll
                for (int ks = 0; ks < 8; ++ks) if (2 * ks <= jout) acc[jout] = MFMA16(*(const LAS bf16x8*)(lds + 65536 + ((jout - 2 * ks) * 64 + lane) * 16), U[ks], acc[jout]);
            } else {
#pragma unroll
                for (int ks = 0; ks < 8; ++ks) if (2 * ks + 1 >= jout) acc[jout] = MFMA16(*(const LAS bf16x8*)(lds + 65536 + ((2 * ks - jout + 1) * 64 + lane) * 16), U[ks], acc[jout]);
            }
        }
    }
    const size_t rowb = (size_t)b * SEQ + (size_t)(chunk - 16) * 16; const int c = g * 16 + kg * 4;
#pragma unroll
    for (int jout = 0; jout < 16; ++jout) { u32x2 w; w.x = cvt_pk_bf16(gelu_t(acc[jout][0]), gelu_t(acc[jout][1])); w.y = cvt_pk_bf16(gelu_t(acc[jout][2]), gelu_t(acc[jout][3]));
        __hip_atomic_store((unsigned long long*)(gy + (rowb + jout) * 512 + c), (unsigned long long)w.x | ((unsigned long long)w.y << 32), __ATOMIC_RELAXED, __HIP_MEMORY_SCOPE_AGENT); }
    __syncthreads();
}

struct CRow { u32x2 g[3], v[3]; };
__device__ __forceinline__ CRow conv_load_row(const bf16_t* up, int ldu, int J, int b, int rr, int col, int jg) {
    CRow R;
#pragma unroll
    for (int k = 0; k < 3; ++k) { const int cc = col - 1 + k; const bool ok = (rr >= 0) && (rr < 128) && (cc >= 0) && (cc < 64);
        if (ok) { const size_t tok = (size_t)b * SEQ + rr * 64 + cc; R.g[k] = *(const u32x2*)(up + tok * ldu + jg); R.v[k] = *(const u32x2*)(up + tok * ldu + J + jg); }
        else { R.g[k] = (u32x2){0u, 0u}; R.v[k] = (u32x2){0u, 0u}; } }
    return R;
}
__device__ __forceinline__ void conv_acc(f32x4& ag, f32x4& av, const CRow& R, const f32x4 (&wg)[9], const f32x4 (&wv)[9], int kh) {
#pragma unroll
    for (int k = 0; k < 3; ++k) { const f32x4 xg = {bflo(R.g[k].x), bfhi(R.g[k].x), bflo(R.g[k].y), bfhi(R.g[k].y)}, xv = {bflo(R.v[k].x), bfhi(R.v[k].x), bflo(R.v[k].y), bfhi(R.v[k].y)};
        ag += wg[kh * 3 + k] * xg; av += wv[kh * 3 + k] * xv; }
}
__device__ __forceinline__ void conv_phase(const bf16_t* up, int J, int j0, const float* convw, const float* convb, bf16_t* act, int bid, int G, int tid) {
    const int ldu = 2 * J, nslab = J / 64, nitems = 4 * 8 * 2 * nslab;
    for (int it = bid; it < nitems; it += G) {
        const int slab = it % nslab; int t = it / nslab; const int half = t & 1; t >>= 1; const int band = t & 7, b = t >> 3;
        const int cgp = tid & 15, col = half * 32 + (tid >> 4), jg = slab * 64 + cgp * 4;
        f32x4 wg[9], wv[9];
#pragma unroll
        for (int k = 0; k < 9; ++k) { wg[k] = *(const f32x4*)(convw + k * F2 + j0 + jg); wv[k] = *(const f32x4*)(convw + k * F2 + FFH + j0 + jg); }
        const f32x4 bg = *(const f32x4*)(convb + j0 + jg), bv = *(const f32x4*)(convb + FFH + j0 + jg);
        const int r0 = band * 16;
        CRow prev = conv_load_row(up, ldu, J, b, r0 - 1, col, jg), cur = conv_load_row(up, ldu, J, b, r0, col, jg);
        for (int r = r0; r < r0 + 16; ++r) {
            const CRow nxt = conv_load_row(up, ldu, J, b, r + 1, col, jg);
            f32x4 ag = bg, av = bv;
            conv_acc(ag, av, prev, wg, wv, 0); conv_acc(ag, av, cur, wg, wv, 1); conv_acc(ag, av, nxt, wg, wv, 2);
            u32x2 w; w.x = cvt_pk_bf16(ag[0] * sigm(ag[0]) * av[0], ag[1] * sigm(ag[1]) * av[1]); w.y = cvt_pk_bf16(ag[2] * sigm(ag[2]) * av[2], ag[3] * sigm(ag[3]) * av[3]);
            *(u32x2*)(act + ((size_t)b * SEQ + r * 64 + col) * J + jg) = w;
            prev = cur; cur = nxt;
        }
    }
}

constexpr int NPHASE = 15;
struct Args { const float* in[32]; float* out; unsigned char* ws; int ph_lo, ph_hi; };

__global__ void __launch_bounds__(NTHR, 2) fwd_kernel(Args a) {
    extern __shared__ __attribute__((aligned(16))) unsigned char lds_raw[];
    LAS unsigned char* lds = (LAS unsigned char*)lds_raw;
    cg::grid_group grid = cg::this_grid();
    const int tid = threadIdx.x, lane = tid & 63, wave = __builtin_amdgcn_readfirstlane(tid >> 6);
    const int G = gridDim.x, bid = blockIdx.x, gw = bid * 8 + wave, NGW = G * 8;
    unsigned char* ws = a.ws;
    const int lo = a.ph_lo, hi = a.ph_hi;
#define IN(k) (lo <= (k) && (k) < hi)
#ifndef PHMASK
#define PHMASK 0x7fff
#endif
#define PHON(k) ((PHMASK >> (k)) & 1)
#define SEAM(k) do { if (IN(k) && IN((k) + 1)) { __builtin_amdgcn_fence(__ATOMIC_RELEASE, "agent"); asm volatile("s_waitcnt vmcnt(0) lgkmcnt(0)" ::: "memory"); \
        grid.sync(); __builtin_amdgcn_fence(__ATOMIC_ACQUIRE, "agent"); asm volatile("s_waitcnt vmcnt(0) lgkmcnt(0)" ::: "memory"); } } while (0)
#if defined(DBG_ZB_AT)
#define DUMPG(k) do { if ((k) == DBG_ZB_AT) { const bf16_t* mp = (const bf16_t*)(ws + WS_ZB); \
      for (int m = gw; m < MTOK; m += NGW) { for (int j = 0; j < 16; ++j) { const int c = lane + 64 * j; a.out[(size_t)m * DM + c] = 2.f + bf2f(mp[(size_t)m * 1024 + c]); } } return; } } while (0)
#elif defined(DBG_GATES_AT)
#define DUMPG(k) do { if ((k) == DBG_GATES_AT) { const bf16_t* mp = (const bf16_t*)(ws + WS_GATES); \
      for (int m = gw; m < MTOK; m += NGW) { for (int j = 0; j < 16; ++j) { const int c = lane + 64 * j; a.out[(size_t)m * DM + c] = 2.f + bf2f(mp[(size_t)m * 2048 + c]) + 4.f * bf2f(mp[(size_t)m * 2048 + 1024 + c]); } } return; } } while (0)
#else
#define DUMPG(k) do { } while (0)
#endif
    float* mod = (float*)(ws + WS_MOD);
    bf16_t* hbuf = (bf16_t*)(ws + WS_HBUF);
    using pg8::Gemm; using pg8::gemm_phase;

    if (PHON(0) && IN(0)) {
        P0Args A; A.c = a.in[1]; A.cctx = a.in[3]; A.wada = a.in[4]; A.bada = a.in[5]; A.w_in = a.in[7]; A.w_glu = a.in[16]; A.w_pa = a.in[22]; A.w_pb = a.in[23]; A.w_out = a.in[25];
        A.w_up = a.in[27]; A.w_down = a.in[30]; A.sgu_w = a.in[20]; A.a_re = a.in[8]; A.a_im = a.in[9]; A.logstep = a.in[10]; A.b_re = a.in[11]; A.b_im = a.in[12]; A.c_re = a.in[13]; A.c_im = a.in[14]; A.dskip = a.in[15];
        for (int it = bid; it < 96 + 64; it += G) {
            if (it < 96) p0_gemv_item(it, A, mod, lds, tid, lane, wave);
            else p0_s5_item(it - 96, A, (bf16_t*)(ws + WS_PFRAG), (bf16_t*)(ws + WS_QFRAG), (bf16_t*)(ws + WS_TFRAG), lds, tid);
        }
        __syncthreads();
        LAS float* scr = (LAS float*)(lds + wave * 16384);
        constexpr int NIT = 1792 + 128 + 256 + 256 + 512 + 2816 + 1408 + 256;
        for (int it = gw; it < NIT; it += NGW) { int r = it;
            if (tr_job(r, A.w_in, 3584, 0, 0, 1024, 3584, (bf16_t*)(ws + WS_WIN), 1024, 0, scr, lane)) continue;
            if (tr_job(r, A.w_glu, 512, 0, 0, 512, 512, (bf16_t*)(ws + WS_WGLU), 512, 0, scr, lane)) continue;
            if (tr_job(r, A.w_pa, 1024, 0, 0, 512, 1024, (bf16_t*)(ws + WS_WPA), 512, 0, scr, lane)) continue;
            if (tr_job(r, A.w_pb, 1024, 0, 0, 512, 1024, (bf16_t*)(ws + WS_WPB), 512, 0, scr, lane)) continue;
            if (tr_job(r, A.w_out, 1024, 0, 0, 1024, 1024, (bf16_t*)(ws + WS_WOUT), 1024, 0, scr, lane)) continue;
            if (tr_job(r, A.w_up, F2, 0, 0, 1024, J1, (bf16_t*)(ws + WS_WUP1), 1024, 0, scr, lane)) continue;
            if (tr_job(r, A.w_up, F2, 0, FFH, 1024, J1, (bf16_t*)(ws + WS_WUP1), 1024, J1, scr, lane)) continue;
            if (tr_job(r, A.w_up, F2, 0, J1, 1024, J2, (bf16_t*)(ws + WS_WUP2), 1024, 0, scr, lane)) continue;
            if (tr_job(r, A.w_up, F2, 0, FFH + J1, 1024, J2, (bf16_t*)(ws + WS_WUP2), 1024, J2, scr, lane)) continue;
            if (tr_job(r, A.w_down, 1024, 0, 0, J1, 1024, (bf16_t*)(ws + WS_WDN1), J1, 0, scr, lane)) continue;
            if (tr_job(r, A.w_down, 1024, J1, 0, J2, 1024, (bf16_t*)(ws + WS_WDN2), J2, 0, scr, lane)) continue;
            { const size_t base = (size_t)r * 512 + lane * 8; const f32x4 v0 = *(const f32x4*)(A.sgu_w + base), v1 = *(const f32x4*)(A.sgu_w + base + 4);
              *(u32x4*)((bf16_t*)(ws + WS_SGUW) + base) = pack8(v0, v1); }
        }
    }
    SEAM(0); DUMPG(0);
    if (PHON(1) && IN(1)) mod_rows(a.in[0], a.in[2], MALL, a.in[6], mod, 0, 1024, hbuf, gw, NGW, lane);
    SEAM(1); DUMPG(1);
    if (PHON(2) && IN(2)) {
        Gemm g{hbuf, (const bf16_t*)(ws + WS_WIN), MALL, 3584, 1024}; OrderX S; S.init(MTOK, 3584, G, bid, 8, 128, 2);
        EpiIn E{(bf16_t*)(ws + WS_UG), (bf16_t*)(ws + WS_ZB), (bf16_t*)(ws + WS_GATES), a.in[24]};
        gemm_phase<EpiIn, OrderX, true, true>(lds, g, S, E);
    }
    SEAM(2); DUMPG(2);
    if (PHON(3) && IN(3)) {
#ifndef NOS5AB
        for (int it = bid; it < 256; it += G) s5ab_item(it, lds, (const bf16_t*)(ws + WS_PFRAG), (const bf16_t*)(ws + WS_UG), (float*)(ws + WS_SBUF), (bf16_t*)(ws + WS_HPREV), a.in[8], a.in[9], a.in[10], tid, lane, wave);
#endif
#ifndef NOSGU
        for (int it = bid; it < 256; it += G) sgu_item(it, lds, (const bf16_t*)(ws + WS_ZB), (const bf16_t*)(ws + WS_SGUW), a.in[21], a.in[18], a.in[19], (bf16_t*)(ws + WS_YB), tid, lane, wave);
#endif
    }
    SEAM(3); DUMPG(3);
    if (PHON(4) && IN(4)) {
        for (int it = bid; it < 512; it += G) s5c_item(it, lds, (const bf16_t*)(ws + WS_QFRAG), (const bf16_t*)(ws + WS_TFRAG), (const bf16_t*)(ws + WS_UG), (const bf16_t*)(ws + WS_HPREV), (bf16_t*)(ws + WS_GY), tid, lane, wave);
    }
    SEAM(4); DUMPG(4);
#if defined(DBG_DUMP) && DBG_DUMP == 1
    { __builtin_amdgcn_fence(__ATOMIC_RELEASE, "agent"); asm volatile("s_waitcnt vmcnt(0) lgkmcnt(0)" ::: "memory"); grid.sync(); __builtin_amdgcn_fence(__ATOMIC_ACQUIRE, "agent"); asm volatile("s_waitcnt vmcnt(0) lgkmcnt(0)" ::: "memory");
      const bf16_t* gyp = (const bf16_t*)(ws + WS_GY); const bf16_t* ybp = (const bf16_t*)(ws + WS_YB);
      for (int m = gw; m < MTOK; m += NGW) { for (int j = 0; j < 8; ++j) { const int c = lane + 64 * j; a.out[(size_t)m * DM + c] = 2.f + bf2f(gyp[(size_t)m * 512 + c]); a.out[(size_t)m * DM + 512 + c] = 2.f + bf2f(ybp[(size_t)m * 512 + c]); } }
      return; }
#endif
    if (PHON(5) && IN(5)) {
        Gemm g{(const bf16_t*)(ws + WS_GY), (const bf16_t*)(ws + WS_WGLU), MTOK, 512, 512}; OrderX S; S.init(MTOK, 512, G, bid);
        EpiGlu E{(const bf16_t*)(ws + WS_GY), (bf16_t*)(ws + WS_YA), a.in[17]};
        gemm_phase<EpiGlu, OrderX, true, true>(lds, g, S, E);
    }
    SEAM(5); DUMPG(5);
#if defined(DBG_DUMP) && DBG_DUMP == 3
    { __builtin_amdgcn_fence(__ATOMIC_RELEASE, "agent"); asm volatile("s_waitcnt vmcnt(0) lgkmcnt(0)" ::: "memory"); grid.sync(); __builtin_amdgcn_fence(__ATOMIC_ACQUIRE, "agent"); asm volatile("s_waitcnt vmcnt(0) lgkmcnt(0)" ::: "memory");
      const bf16_t* mp = (const bf16_t*)(ws + WS_YA);
      for (int m = gw; m < MTOK; m += NGW) { for (int j = 0; j < 16; ++j) { const int c = lane + 64 * j; a.out[(size_t)m * DM + c] = 2.f + bf2f(mp[(size_t)m * 512 + (c & 511)]); } }
      return; }
#endif
    if (PHON(6) && IN(6)) {
        { Gemm g{(const bf16_t*)(ws + WS_YA), (const bf16_t*)(ws + WS_WPA), MTOK, 1024, 512}; OrderX S; S.init(MTOK, 1024, G, bid);
          EpiMergeA E{(const bf16_t*)(ws + WS_GATES), (float*)(ws + WS_TMP)};
          gemm_phase<EpiMergeA, OrderX, true, true>(lds, g, S, E); }
#if defined(DBG_DUMP) && DBG_DUMP == 5
    { __builtin_amdgcn_fence(__ATOMIC_RELEASE, "agent"); asm volatile("s_waitcnt vmcnt(0) lgkmcnt(0)" ::: "memory"); grid.sync(); __builtin_amdgcn_fence(__ATOMIC_ACQUIRE, "agent"); asm volatile("s_waitcnt vmcnt(0) lgkmcnt(0)" ::: "memory");
      const float* mp = (const float*)(ws + WS_TMP);
      for (int m = gw; m < MTOK; m += NGW) { for (int j = 0; j < 16; ++j) { const int c = lane + 64 * j; a.out[(size_t)m * DM + c] = 2.f + mp[(size_t)m * 1024 + c]; } }
      return; }
#endif
#if defined(DBG_DUMP) && DBG_DUMP == 6
    { __builtin_amdgcn_fence(__ATOMIC_RELEASE, "agent"); asm volatile("s_waitcnt vmcnt(0) lgkmcnt(0)" ::: "memory"); grid.sync(); __builtin_amdgcn_fence(__ATOMIC_ACQUIRE, "agent"); asm volatile("s_waitcnt vmcnt(0) lgkmcnt(0)" ::: "memory");
      const bf16_t* mp = (const bf16_t*)(ws + WS_GATES);
      for (int m = gw; m < MTOK; m += NGW) { for (int j = 0; j < 16; ++j) { const int c = lane + 64 * j; a.out[(size_t)m * DM + c] = 2.f + bf2f(mp[(size_t)m * 2048 + c]) + 4.f * bf2f(mp[(size_t)m * 2048 + 1024 + c]); } }
      return; }
#endif
        { Gemm g{(const bf16_t*)(ws + WS_YB), (const bf16_t*)(ws + WS_WPB), MTOK, 1024, 512}; OrderX S; S.init(MTOK, 1024, G, bid);
          EpiMergeB E{(const bf16_t*)(ws + WS_GATES), (const float*)(ws + WS_TMP), (bf16_t*)(ws + WS_MBUF)};
          gemm_phase<EpiMergeB, OrderX, true, true>(lds, g, S, E); }
    }
    SEAM(6); DUMPG(6);
#if defined(DBG_DUMP) && DBG_DUMP == 4
    { __builtin_amdgcn_fence(__ATOMIC_RELEASE, "agent"); asm volatile("s_waitcnt vmcnt(0) lgkmcnt(0)" ::: "memory"); grid.sync(); __builtin_amdgcn_fence(__ATOMIC_ACQUIRE, "agent"); asm volatile("s_waitcnt vmcnt(0) lgkmcnt(0)" ::: "memory");
      const bf16_t* mp = (const bf16_t*)(ws + WS_MBUF);
      for (int m = gw; m < MTOK; m += NGW) { for (int j = 0; j < 16; ++j) { const int c = lane + 64 * j; a.out[(size_t)m * DM + c] = 2.f + bf2f(mp[(size_t)m * 1024 + c]); } }
      return; }
#endif
    if (PHON(7) && IN(7)) {
        Gemm g{(const bf16_t*)(ws + WS_MBUF), (const bf16_t*)(ws + WS_WOUT), MTOK, 1024, 1024}; OrderX S; S.init(MTOK, 1024, G, bid);
        EpiRes E{a.in[0], a.out, mod + 2048};
        gemm_phase<EpiRes, OrderX, true, true>(lds, g, S, E);
    }
    SEAM(7); DUMPG(7);
#if defined(DBG_DUMP) && DBG_DUMP == 2
    return;
#endif
    if (PHON(8) && IN(8)) mod_rows2(a.out, nullptr, MTOK, a.in[26], mod, 3072, 4096, hbuf, gw, NGW, lane);
    SEAM(8); DUMPG(8);
    if (PHON(9) && IN(9)) {
        Gemm g{hbuf, (const bf16_t*)(ws + WS_WUP1), MTOK, 2 * J1, 1024}; OrderX S; S.init(MTOK, 2 * J1, G, bid);
        EpiPlain E{(bf16_t*)(ws + WS_UPB), 2 * J1};
        gemm_phase<EpiPlain, OrderX, true, true>(lds, g, S, E);
    }
    SEAM(9); DUMPG(9);
    if (PHON(10) && IN(10)) conv_phase((const bf16_t*)(ws + WS_UPB), J1, 0, a.in[28], a.in[29], (bf16_t*)(ws + WS_ACT1), bid, G, tid);
    SEAM(10); DUMPG(10);
    if (PHON(11) && IN(11)) {
        Gemm g{hbuf, (const bf16_t*)(ws + WS_WUP2), MTOK, 2 * J2, 1024}; OrderX S; S.init(MTOK, 2 * J2, G, bid);
        EpiPlain E{(bf16_t*)(ws + WS_UPB), 2 * J2};
        gemm_phase<EpiPlain, OrderX, true, true>(lds, g, S, E);
    }
    SEAM(11); DUMPG(11);
    if (PHON(12) && IN(12)) conv_phase((const bf16_t*)(ws + WS_UPB), J2, J1, a.in[28], a.in[29], (bf16_t*)(ws + WS_ACT2), bid, G, tid);
    SEAM(12); DUMPG(12);
    if (PHON(13) && IN(13)) {
        { Gemm g{(const bf16_t*)(ws + WS_ACT1), (const bf16_t*)(ws + WS_WDN1), MTOK, 1024, J1}; OrderX S; S.init(MTOK, 1024, G, bid);
          EpiRes E{a.out, a.out, mod + 5120};
          gemm_phase<EpiRes, OrderX, true, true>(lds, g, S, E); }
        { Gemm g{(const bf16_t*)(ws + WS_ACT2), (const bf16_t*)(ws + WS_WDN2), MTOK, 1024, J2}; OrderX S; S.init(MTOK, 1024, G, bid);
          EpiRes E{a.out, a.out, mod + 5120};
          gemm_phase<EpiRes, OrderX, true, true>(lds, g, S, E); }
    }
    SEAM(13); DUMPG(13);
    if (PHON(14) && IN(14)) {
        const float* gf = a.in[31];
        for (int m = gw; m < MTOK; m += NGW) { f32x4* xr = (f32x4*)(a.out + (size_t)m * DM);
            f32x4 v[4]; float s = 0.f;
#pragma unroll
            for (int j = 0; j < 4; ++j) { v[j] = xr[lane + 64 * j]; s += (v[j][0] * v[j][0] + v[j][1] * v[j][1]) + (v[j][2] * v[j][2] + v[j][3] * v[j][3]); }
            const float rstd = rsqrtf(wave_sum(s) * (1.f / DM) + EPS);
#pragma unroll
            for (int j = 0; j < 4; ++j) xr[lane + 64 * j] = (v[j] * rstd) * ((const f32x4*)gf)[lane + 64 * j]; }
    }
#undef IN
#undef SEAM
}

#ifndef MK_SPLIT
#define MK_SPLIT 0
#endif
extern "C" void kernel_launch(void* const* d_in, const int* in_sizes, int n_in, void* d_out, int out_size, void* d_ws, size_t ws_size, hipStream_t stream) {
    static int grid = 0;
    if (grid == 0) {
        if (n_in != 32 || out_size != MTOK * DM || ws_size < WS_END) { fprintf(stderr, "kernel_launch: unexpected shapes (n_in %d out %d ws %zu)\n", n_in, out_size, ws_size); grid = -1; return; }
        int dev = 0, cus = 0, per_cu = 0;
        hipGetDevice(&dev); hipDeviceGetAttribute(&cus, hipDeviceAttributeMultiprocessorCount, dev);
        if (hipFuncSetAttribute((const void*)fwd_kernel, hipFuncAttributeMaxDynamicSharedMemorySize, LDS_BYTES) != hipSuccess) { fprintf(stderr, "kernel_launch: hipFuncSetAttribute failed\n"); grid = -1; return; }
        if (hipOccupancyMaxActiveBlocksPerMultiprocessor(&per_cu, (const void*)fwd_kernel, NTHR, LDS_BYTES) != hipSuccess || per_cu < 1) { fprintf(stderr, "kernel_launch: occupancy query gave %d\n", per_cu); per_cu = 1; }
        (void)hipGetLastError();
        grid = cus * per_cu;
    }
    if (grid < 0) return;
    Args a{};
    for (int i = 0; i < 32; ++i) a.in[i] = (const float*)d_in[i];
    a.out = (float*)d_out; a.ws = (unsigned char*)d_ws;
#if MK_SPLIT
    for (int p = 0; p < NPHASE; ++p) { a.ph_lo = p; a.ph_hi = p + 1; hipLaunchKernelGGL(fwd_kernel, dim3(grid), dim3(NTHR), LDS_BYTES, stream, a); }
#else
    a.ph_lo = 0; a.ph_hi = NPHASE;
    void* args[] = {&a};
    hipError_t e = hipLaunchCooperativeKernel((const void*)fwd_kernel, dim3(grid), dim3(NTHR), args, LDS_BYTES, stream);
    if (e != hipSuccess) fprintf(stderr, "kernel_launch: cooperative launch failed: %s (grid %d)\n", hipGetErrorString(e), grid);
#endif
}
```

```cpp
#include <hip/hip_runtime.h>
#include <hip/hip_cooperative_groups.h>
#include <cstdio>
#include <cstdint>
namespace cg = cooperative_groups;
namespace pg8 {
#define PG8_LAS __attribute__((address_space(3)))
typedef unsigned short bf16_t;
typedef short bf16x8 __attribute__((ext_vector_type(8)));
typedef float f32x4 __attribute__((ext_vector_type(4)));
typedef unsigned u32x4 __attribute__((ext_vector_type(4)));
constexpr int BM = 256, BK = 64, HALF = 128, HTB = HALF * BK * 2  , STAGE_BYTES = 8 * HTB, NXCD = 8, WGM = 8;

__host__ __device__ __forceinline__ int lds_byte(int r, int c) { const int st = (r >> 4) * 2 + (c >> 5), rr = r & 15, cc = c & 31, ob = rr * 64 + cc * 2; return st * 1024 + (ob ^ (((ob >> 9) & 1) << 5)); }
__host__ __device__ __forceinline__ void stage_rc(int b, int& R, int& C) { const int st = b / 1024, sb = b % 1024, swz = sb ^ (((sb >> 9) & 1) << 5); R = (st >> 1) * 16 + swz / 64; C = (st & 1) * 32 + (swz % 64) / 2; }
__host__ __device__ __forceinline__ int perm32(int rho) { const int n = rho >> 4, i = rho & 15; return 8 * (i >> 2) + 4 * n + (i & 3); }

struct Unit { int pm, pn; };
struct Gemm { const bf16_t* A; const bf16_t* Bt; int M, N, K; };

struct StaticOrder {
    int nM, nN, nwg, G, c;
    __host__ __device__ void init(int M, int N, int G_, int c_) { nM = M / BM; nN = N / BM; nwg = nM * nN; G = G_; c = c_; }
    __host__ __device__ bool next(int i, Unit& u) const {
        const long L = (long)i * G + c; if (L >= nwg) return false;
        int wgid = (int)L; { const int q = nwg / NXCD, r = nwg % NXCD, xcd = wgid % NXCD, off = wgid / NXCD; wgid = (xcd < r ? xcd * (q + 1) : r * (q + 1) + (xcd - r) * q) + off; }
        const int nig = WGM * nN, gid = wgid / nig, fm = gid * WGM, gsz = (nM - fm) < WGM ? (nM - fm) : WGM;
        u.pm = fm + ((wgid % nig) % gsz); u.pn = (wgid % nig) / gsz; return true;
    }
    __device__ __forceinline__ void a_ready(const Unit&) const {}
    __device__ __forceinline__ void done(const Unit&) const {}
};

__device__ __forceinline__ unsigned cvt_pk_bf16(float lo, float hi) { unsigned r; asm volatile("v_cvt_pk_bf16_f32 %0, %1, %2" : "=v"(r) : "v"(lo), "v"(hi)); return r; }
template <class Epi, class Sched, bool ALIGN_EPI = false, bool SP2 = false>
__device__ __forceinline__ void gemm_phase(PG8_LAS unsigned char* lds, const Gemm g, const Sched& S, const Epi& E) {
    const int tid = threadIdx.x, wid = __builtin_amdgcn_readfirstlane(tid >> 6), lane = tid & 63, wr = wid >> 2, wc = wid & 3, fr = lane & 15, fq = lane >> 4;
    const int K = g.K, nt = K / BK;
    unsigned voffA[2], voffB[2];
#pragma unroll
    for (int i = 0; i < 2; ++i) { int R, C; stage_rc(tid * 16 + i * 8192, R, C); const int Rb = Epi::PERM ? ((R & ~31) + perm32(R & 31)) : R;
        voffA[i] = (unsigned)(R * K + C) * 2u; voffB[i] = (unsigned)(Rb * K + C) * 2u; }
    const size_t kstep = (size_t)(BK * 2);
    const size_t hstep = (size_t)HALF * K * 2;
    const size_t tstep = 2 * hstep;
    const unsigned ldsw = (unsigned)wid * 1024u;
    const int aoff = lds_byte(wr * 64 + fr, fq * 8), boff = lds_byte(wc * 32 + fr, fq * 8);
#define PG8_SA(b, h) (((b) * 2 + (h)) * HTB)
#define PG8_SB(b, h) ((4 + (b) * 2 + (h)) * HTB)
#define PG8_STAGE(bufoff, gbase, voff) do { _Pragma("unroll") for (int _i = 0; _i < 2; ++_i) \
        __builtin_amdgcn_global_load_lds((const unsigned*)((const char*)(gbase) + (voff)[_i]), (PG8_LAS unsigned*)(lds + (bufoff) + ldsw + _i * 8192), 16, 0, 0); } while (0)
#define PG8_LDA(dst, b, h) do { _Pragma("unroll") for (int m = 0; m < 4; ++m) _Pragma("unroll") for (int k = 0; k < 2; ++k) dst[m][k] = *(const PG8_LAS bf16x8*)(lds + PG8_SA(b, h) + aoff + m * 2048 + k * 1024); } while (0)
#define PG8_LDB(dst, b, h) do { _Pragma("unroll") for (int n = 0; n < 2; ++n) _Pragma("unroll") for (int k = 0; k < 2; ++k) dst[n][k] = *(const PG8_LAS bf16x8*)(lds + PG8_SB(b, h) + boff + n * 2048 + k * 1024); } while (0)
#define PG8_MMA(ai, bj, At, Bt) do { __builtin_amdgcn_s_setprio(1); _Pragma("unroll") for (int m = 0; m < 4; ++m) _Pragma("unroll") for (int n = 0; n < 2; ++n) _Pragma("unroll") for (int k = 0; k < 2; ++k) \
        acc[ai][bj][m][n] = __builtin_amdgcn_mfma_f32_16x16x32_bf16(Bt[n][k], At[m][k], acc[ai][bj][m][n], 0, 0, 0); __builtin_amdgcn_s_setprio(0); } while (0)
#define PG8_WAIT_V(n) asm volatile("s_waitcnt vmcnt(" #n ")" ::: "memory")
#define PG8_WAIT_L(n) asm volatile("s_waitcnt lgkmcnt(" #n ")" ::: "memory")
#define PG8_BAR __builtin_amdgcn_s_barrier()
#define PG8_SCHED __builtin_amdgcn_sched_barrier(0)
    Unit cur, nxt; int ui = 0;
    if (!S.next(0, cur)) return;
    f32x4 acc[2][2][4][2];
#pragma unroll
    for (int a = 0; a < 2; ++a)
#pragma unroll
        for (int b = 0; b < 2; ++b)
#pragma unroll
            for (int m = 0; m < 4; ++m)
#pragma unroll
                for (int n = 0; n < 2; ++n) acc[a][b][m][n] = (f32x4){0.f, 0.f, 0.f, 0.f};
    bf16x8 At[4][2], B0[2][2], B1[2][2];
    const char* cA = (const char*)g.A + (size_t)cur.pm * tstep; const char* cB = (const char*)g.Bt + (size_t)cur.pn * tstep;
    S.a_ready(cur);
    if constexpr (SP2) {
        PG8_STAGE(PG8_SB(0, 0), cB, voffB); PG8_STAGE(PG8_SB(0, 1), cB + hstep, voffB); PG8_STAGE(PG8_SA(0, 0), cA, voffA); PG8_STAGE(PG8_SA(0, 1), cA + hstep, voffA);
        if (wr == 1) PG8_BAR;
        PG8_WAIT_V(2); PG8_BAR;
        PG8_STAGE(PG8_SB(1, 0), cB + kstep, voffB); PG8_STAGE(PG8_SA(1, 0), cA + kstep, voffA); PG8_STAGE(PG8_SB(1, 1), cB + hstep + kstep, voffB);
        PG8_WAIT_V(6); PG8_BAR;
    } else {
        PG8_STAGE(PG8_SB(0, 0), cB, voffB); PG8_STAGE(PG8_SA(0, 0), cA, voffA); PG8_STAGE(PG8_SB(0, 1), cB + hstep, voffB); PG8_STAGE(PG8_SA(0, 1), cA + hstep, voffA);
        if (wr == 1) PG8_BAR;
        PG8_WAIT_V(4); PG8_BAR;
        PG8_STAGE(PG8_SB(1, 0), cB + kstep, voffB); PG8_STAGE(PG8_SA(1, 0), cA + kstep, voffA); PG8_STAGE(PG8_SB(1, 1), cB + hstep + kstep, voffB);
        PG8_WAIT_V(6); PG8_BAR;
    }
    for (;;) {
        const bool has_next = S.next(ui + 1, nxt);
        const char* nA = has_next ? (const char*)g.A + (size_t)nxt.pm * tstep : cA; const char* nB = has_next ? (const char*)g.Bt + (size_t)nxt.pn * tstep : cB;
        for (int t = 0; t < nt; t += 2) {
            const bool last = (t == nt - 2);
            if constexpr (Epi::MIDHOOK) { if (t == (nt >> 1)) E.mid(acc, cur, wr, wc, fr, fq); }
            const char* a1 = cA + (size_t)(t + 1) * kstep;
            const char* a2 = last ? nA : cA + (size_t)(t + 2) * kstep; const char* b2 = last ? nB : cB + (size_t)(t + 2) * kstep;
            const char* a3 = a2 + kstep; const char* b3 = b2 + kstep;
            if (last && has_next) S.a_ready(nxt);
            if constexpr (SP2) {
            PG8_LDB(B0, 0, 0); PG8_LDB(B1, 0, 1); PG8_SCHED; PG8_LDA(At, 0, 0); PG8_STAGE(PG8_SA(1, 1), a1 + hstep, voffA);
            PG8_WAIT_V(8); PG8_WAIT_L(0); PG8_BAR; PG8_MMA(0, 0, At, B0); PG8_MMA(0, 1, At, B1); PG8_BAR; PG8_SCHED;
            PG8_LDA(At, 0, 1); PG8_STAGE(PG8_SB(0, 0), b2, voffB); PG8_STAGE(PG8_SB(0, 1), b2 + hstep, voffB); PG8_STAGE(PG8_SA(0, 0), a2, voffA);
            PG8_WAIT_V(8); PG8_WAIT_L(0); PG8_BAR; PG8_MMA(1, 0, At, B0); PG8_MMA(1, 1, At, B1); PG8_BAR; PG8_SCHED;
            PG8_LDB(B0, 1, 0); PG8_LDB(B1, 1, 1); PG8_SCHED; PG8_LDA(At, 1, 0); PG8_STAGE(PG8_SA(0, 1), a2 + hstep, voffA);
            PG8_WAIT_V(8); PG8_WAIT_L(0); PG8_BAR; PG8_MMA(0, 0, At, B0); PG8_MMA(0, 1, At, B1); PG8_BAR; PG8_SCHED;
            PG8_LDA(At, 1, 1); PG8_STAGE(PG8_SB(1, 0), b3, voffB); PG8_STAGE(PG8_SB(1, 1), b3 + hstep, voffB); PG8_STAGE(PG8_SA(1, 0), a3, voffA);
            PG8_WAIT_V(8); PG8_WAIT_L(0); PG8_BAR; PG8_MMA(1, 0, At, B0); PG8_MMA(1, 1, At, B1); PG8_BAR; PG8_SCHED;
            } else {
            PG8_LDB(B0, 0, 0); PG8_SCHED; PG8_LDA(At, 0, 0); PG8_STAGE(PG8_SA(1, 1), a1 + hstep, voffA);
            PG8_WAIT_L(8); PG8_BAR; PG8_WAIT_L(0); PG8_MMA(0, 0, At, B0); PG8_BAR; PG8_SCHED;
            PG8_LDB(B1, 0, 1); PG8_STAGE(PG8_SB(0, 0), b2, voffB);
            PG8_BAR; PG8_WAIT_L(0); PG8_MMA(0, 1, At, B1); PG8_BAR;
            PG8_LDA(At, 0, 1); PG8_STAGE(PG8_SA(0, 0), a2, voffA);
            PG8_BAR; PG8_WAIT_L(0); PG8_MMA(1, 0, At, B0); PG8_BAR; PG8_SCHED;
            PG8_STAGE(PG8_SB(0, 1), b2 + hstep, voffB);
            PG8_WAIT_V(6); PG8_BAR; PG8_MMA(1, 1, At, B1); PG8_BAR;
            PG8_LDB(B0, 1, 0); PG8_SCHED; PG8_LDA(At, 1, 0); PG8_STAGE(PG8_SA(0, 1), a2 + hstep, voffA);
            PG8_WAIT_L(8); PG8_BAR; PG8_WAIT_L(0); PG8_MMA(0, 0, At, B0); PG8_BAR; PG8_SCHED;
            PG8_LDB(B1, 1, 1); PG8_STAGE(PG8_SB(1, 0), b3, voffB);
            PG8_BAR; PG8_WAIT_L(0); PG8_MMA(0, 1, At, B1); PG8_BAR;
            PG8_LDA(At, 1, 1); PG8_STAGE(PG8_SA(1, 0), a3, voffA);
            PG8_BAR; PG8_WAIT_L(0); PG8_MMA(1, 0, At, B0); PG8_BAR; PG8_SCHED;
            PG8_STAGE(PG8_SB(1, 1), b3 + hstep, voffB);
            PG8_WAIT_V(6); PG8_BAR; PG8_MMA(1, 1, At, B1); PG8_BAR;
            }
        }
        if constexpr (ALIGN_EPI) { if (wr == 0) PG8_BAR; }
        if constexpr (!Epi::AFTER_DRAIN) { E(acc, cur, wr, wc, fr, fq); S.done(cur); }
        if (!has_next) break;
#pragma unroll
        for (int a = 0; a < 2; ++a)
#pragma unroll
            for (int b = 0; b < 2; ++b)
#pragma unroll
                for (int m = 0; m < 4; ++m)
#pragma unroll
                    for (int n = 0; n < 2; ++n) acc[a][b][m][n] = (f32x4){0.f, 0.f, 0.f, 0.f};
        cur = nxt; cA = nA; cB = nB; ++ui;
        if constexpr (ALIGN_EPI) { if (wr == 1) PG8_BAR; }
    }
    PG8_WAIT_V(0);
    if constexpr (!ALIGN_EPI) { if (wr == 0) PG8_BAR; }
    PG8_BAR;
    if constexpr (Epi::AFTER_DRAIN) { E.fused(acc, cur, wr, wc, fr, fq, lds, wid, lane); S.done(cur); }
#undef PG8_SA
#undef PG8_SB
#undef PG8_STAGE
#undef PG8_LDA
#undef PG8_LDB
#undef PG8_MMA
#undef PG8_WAIT_V
#undef PG8_WAIT_L
#undef PG8_BAR
#undef PG8_SCHED
}
}

#define LAS __attribute__((address_space(3)))
using pg8::bf16_t; using pg8::bf16x8; using pg8::f32x4; using pg8::u32x4; using pg8::Unit;
typedef unsigned u32x2 __attribute__((ext_vector_type(2)));
typedef float f32x2_t __attribute__((ext_vector_type(2)));
typedef __bf16 bf16x2_t __attribute__((ext_vector_type(2)));
__device__ __forceinline__ unsigned cvt_pk_bf16(float lo, float hi) { f32x2_t v = {lo, hi}; bf16x2_t b = __builtin_convertvector(v, bf16x2_t); return __builtin_bit_cast(unsigned, b); }

constexpr int DM = 1024, NB = 4, SEQ = 8192, MTOK = NB * SEQ, CTXL = 256, MCTX = NB * CTXL, MALL = MTOK + MCTX;
constexpr int LTOT = CTXL + SEQ, NCH = LTOT / 16, NMOD = 6 * DM;
constexpr int FFH = 2816, F2 = 2 * FFH, J1 = 1536, J2 = 1280;
constexpr int NTHR = 512, LDS_BYTES = 147456;
constexpr float EPS = 1e-6f;

constexpr size_t MiB = 1u << 20;
constexpr size_t WS_WUP1 = 0, WS_WUP2 = 6 * MiB, WS_WDN1 = 11 * MiB, WS_WDN2 = 14 * MiB;
constexpr size_t WS_WIN = 17 * MiB, WS_WGLU = 24 * MiB, WS_WPA = 24 * MiB + 512 * 1024, WS_WPB = 25 * MiB + 512 * 1024, WS_WOUT = 26 * MiB + 512 * 1024;
constexpr size_t WS_PFRAG = 29 * MiB, WS_QFRAG = 33 * MiB, WS_TFRAG = 37 * MiB, WS_SGUW = 38 * MiB, WS_MOD = 38 * MiB + 512 * 1024, WS_BAR = 39 * MiB;
constexpr size_t WS_HBUF = 40 * MiB, WS_ZB = 106 * MiB, WS_UG = 170 * MiB, WS_GATES = 203 * MiB, WS_SBUF = 331 * MiB, WS_HPREV = 397 * MiB,
                 WS_GY = 462 * MiB, WS_YAB = 40 * MiB, WS_MBUF = 331 * MiB;
constexpr size_t WS_UPB = 106 * MiB, WS_ACT1 = 298 * MiB, WS_ACT2 = 394 * MiB, WS_END = 474 * MiB;

__device__ __forceinline__ float bflo(unsigned w) { return __builtin_bit_cast(float, w << 16); }
__device__ __forceinline__ float bfhi(unsigned w) { return __builtin_bit_cast(float, w & 0xffff0000u); }
__device__ __forceinline__ float bf2f(bf16_t h) { return __builtin_bit_cast(float, ((unsigned)h) << 16); }
__device__ __forceinline__ bf16_t f2bf(float f) { unsigned u = __builtin_bit_cast(unsigned, f); return (bf16_t)((u + 0x7fffu + ((u >> 16) & 1u)) >> 16); }
__device__ __forceinline__ float sigm(float v) { return __builtin_amdgcn_rcpf(1.f + __expf(-v)); }
__device__ __forceinline__ float gelu_t(float x) { const float t = 1.5957691216057308f * (x + 0.044715f * x * x * x); return x * sigm(t); }
__device__ __forceinline__ float wave_sum(float v) {
#pragma unroll
    for (int o = 1; o < 64; o <<= 1) v += __shfl_xor(v, o);
    return v;
}
__device__ __forceinline__ u32x4 pack8(f32x4 a, f32x4 b) { u32x4 w; w.x = cvt_pk_bf16(a[0], a[1]); w.y = cvt_pk_bf16(a[2], a[3]); w.z = cvt_pk_bf16(b[0], b[1]); w.w = cvt_pk_bf16(b[2], b[3]); return w; }
__device__ __forceinline__ void unpack8(u32x4 w, f32x4& a, f32x4& b) { a = (f32x4){bflo(w.x), bfhi(w.x), bflo(w.y), bfhi(w.y)}; b = (f32x4){bflo(w.z), bfhi(w.z), bflo(w.w), bfhi(w.w)}; }
#define LDS_WAIT() asm volatile("s_waitcnt lgkmcnt(0)" ::: "memory")
#define MFMA16(a, b, c) __builtin_amdgcn_mfma_f32_16x16x32_bf16((a), (b), (c), 0, 0, 0)

struct OrderX {
    int nM, nN, nwg, G, c, nExtra, xpm0, xnN;
    __device__ void init(int M, int N, int G_, int c_, int nExtra_ = 0, int xpm0_ = 0, int xnN_ = 1) { nM = M / 256; nN = N / 256; nwg = nM * nN; G = G_; c = c_; nExtra = nExtra_; xpm0 = xpm0_; xnN = xnN_; }
    __device__ bool next(int i, Unit& u) const {
        const long L = (long)i * G + c; if (L >= nwg + nExtra) return false;
        if (L >= nwg) { const int e = (int)L - nwg; u.pm = xpm0 + e / xnN; u.pn = e % xnN; return true; }
        int wgid = (int)L; { const int q = nwg / 8, r = nwg % 8, xcd = wgid % 8, off = wgid / 8; wgid = (xcd < r ? xcd * (q + 1) : r * (q + 1) + (xcd - r) * q) + off; }
        const int nig = 8 * nN, gid = wgid / nig, fm = gid * 8, gsz = (nM - fm) < 8 ? (nM - fm) : 8;
        u.pm = fm + ((wgid % nig) % gsz); u.pn = (wgid % nig) / gsz; return true;
    }
    __device__ __forceinline__ void a_ready(const Unit&) const {}
    __device__ __forceinline__ void done(const Unit&) const {}
};

#define EPI_HEAD const int row0 = u.pm * 256 + wr * 64 + fr; const int col0 = u.pn * 256 + wc * 32 + 8 * fq;
#define EPI_LOOP _Pragma("unroll") for (int ai = 0; ai < 2; ++ai) _Pragma("unroll") for (int m = 0; m < 4; ++m) _Pragma("unroll") for (int bj = 0; bj < 2; ++bj)

struct EpiIn {
    static constexpr bool PERM = true, AFTER_DRAIN = false, MIDHOOK = false;
    bf16_t* ug; bf16_t* zb; bf16_t* gates; const float* bgate;
    __device__ __forceinline__ void operator()(const f32x4 (&acc)[2][2][4][2], const Unit& u, int wr, int wc, int fr, int fq) const {
        EPI_HEAD
        if (u.pn < 2) {
            EPI_LOOP { const int row = row0 + ai * 128 + m * 16, c = col0 + bj * 128;
                int b, pos; if (row < MTOK) { b = row >> 13; pos = CTXL + (row & (SEQ - 1)); } else { const int rr = row - MTOK; b = rr >> 8; pos = rr & (CTXL - 1); }
                const int g = c >> 4, hh = c & 15;
                *(u32x4*)(ug + ((size_t)(b * 32 + g) * LTOT + pos) * 16 + hh) = pack8(acc[ai][bj][m][0], acc[ai][bj][m][1]); }
        } else if (u.pn < 6) {
            EPI_LOOP { const int row = row0 + ai * 128 + m * 16, c = col0 + bj * 128 - 512;
                f32x4 v0 = acc[ai][bj][m][0], v1 = acc[ai][bj][m][1];
#pragma unroll
                for (int e = 0; e < 4; ++e) { v0[e] = gelu_t(v0[e]); v1[e] = gelu_t(v1[e]); }
                *(u32x4*)(zb + (size_t)row * 1024 + c) = pack8(v0, v1); }
        } else {
            const int jc = (u.pn - 6) * 128 + wc * 32 + 8 * fq;
            f32x4 ba[2], bb[2];
            ba[0] = *(const f32x4*)(bgate + jc); ba[1] = *(const f32x4*)(bgate + jc + 4); bb[0] = *(const f32x4*)(bgate + 1024 + jc); bb[1] = *(const f32x4*)(bgate + 1024 + jc + 4);
#pragma unroll
            for (int ai = 0; ai < 2; ++ai)
#pragma unroll
                for (int m = 0; m < 4; ++m) { const int row = row0 + ai * 128 + m * 16;
                    f32x4 rr[2], gb[2];
#pragma unroll
                    for (int h = 0; h < 2; ++h)
#pragma unroll
                        for (int e = 0; e < 4; ++e) { const float ga_ = sigm(acc[ai][0][m][h][e] + ba[h][e]); const float eb = __expf(-(acc[ai][1][m][h][e] + bb[h][e]));
                            gb[h][e] = __builtin_amdgcn_rcpf(1.f + eb); rr[h][e] = ga_ * (1.f + eb); }
                    *(u32x4*)(gates + (size_t)row * 2048 + jc) = pack8(rr[0], rr[1]); *(u32x4*)(gates + (size_t)row * 2048 + 1024 + jc) = pack8(gb[0], gb[1]); }
        }
    }
};
struct EpiGlu {
    static constexpr bool PERM = true, AFTER_DRAIN = false, MIDHOOK = false;
    const bf16_t* gy; bf16_t* ya; const float* bias;
    __device__ __forceinline__ void operator()(const f32x4 (&acc)[2][2][4][2], const Unit& u, int wr, int wc, int fr, int fq) const {
        EPI_HEAD
        f32x4 bv[2][2];
#pragma unroll
        for (int bj = 0; bj < 2; ++bj) { bv[bj][0] = *(const f32x4*)(bias + col0 + bj * 128); bv[bj][1] = *(const f32x4*)(bias + col0 + bj * 128 + 4); }
        EPI_LOOP { const int row = row0 + ai * 128 + m * 16, c = col0 + bj * 128;
            f32x4 g0, g1; unpack8(*(const u32x4*)(gy + (size_t)row * 512 + c), g0, g1);
            f32x4 v0 = acc[ai][bj][m][0] + bv[bj][0], v1 = acc[ai][bj][m][1] + bv[bj][1];
#pragma unroll
            for (int e = 0; e < 4; ++e) { v0[e] = g0[e] * sigm(v0[e]); v1[e] = g1[e] * sigm(v1[e]); }
            *(u32x4*)(ya + (size_t)row * 1024 + c) = pack8(v0, v1); }
    }
};
struct EpiMerge {
    static constexpr bool PERM = true, AFTER_DRAIN = false, MIDHOOK = true;
    const bf16_t* gates; bf16_t* mb;
    __device__ __forceinline__ void mid(f32x4 (&acc)[2][2][4][2], const Unit& u, int wr, int wc, int fr, int fq) const {
        EPI_HEAD
        const char* gb_ = (const char*)gates;
        unsigned base = ((unsigned)row0 * 2048u + (unsigned)col0) * 2u;
        asm volatile("" : "+v"(base));
        EPI_LOOP { const unsigned off = base + (unsigned)(ai * 128 + m * 16) * 4096u + (unsigned)bj * 256u;
            f32x4 a0, a1; unpack8(*(const u32x4*)(gb_ + off), a0, a1);
            acc[ai][bj][m][0] *= a0; acc[ai][bj][m][1] *= a1;
            if (bj == 1 && (m & 1)) __builtin_amdgcn_sched_barrier(0); }
    }
    __device__ __forceinline__ void operator()(const f32x4 (&acc)[2][2][4][2], const Unit& u, int wr, int wc, int fr, int fq) const {
        EPI_HEAD
        EPI_LOOP { const int row = row0 + ai * 128 + m * 16, c = col0 + bj * 128;
            f32x4 b0, b1; unpack8(*(const u32x4*)(gates + (size_t)row * 2048 + 1024 + c), b0, b1);
            *(u32x4*)(mb + (size_t)row * 1024 + c) = pack8(b0 * acc[ai][bj][m][0], b1 * acc[ai][bj][m][1]); }
    }
};
struct EpiRes {
    static constexpr bool PERM = true, AFTER_DRAIN = false, MIDHOOK = false;
    const float* base; float* out; const float* gate;
    __device__ __forceinline__ void operator()(const f32x4 (&acc)[2][2][4][2], const Unit& u, int wr, int wc, int fr, int fq) const {
        EPI_HEAD
        const int b = (u.pm * 256) >> 13;
        f32x4 gv[2][2];
#pragma unroll
        for (int bj = 0; bj < 2; ++bj) { gv[bj][0] = *(const f32x4*)(gate + b * NMOD + col0 + bj * 128); gv[bj][1] = *(const f32x4*)(gate + b * NMOD + col0 + bj * 128 + 4); }
        EPI_LOOP { const int row = row0 + ai * 128 + m * 16, c = col0 + bj * 128;
            const f32x4 x0 = *(const f32x4*)(base + (size_t)row * 1024 + c), x1 = *(const f32x4*)(base + (size_t)row * 1024 + c + 4);
            *(f32x4*)(out + (size_t)row * 1024 + c) = x0 + gv[bj][0] * acc[ai][bj][m][0]; *(f32x4*)(out + (size_t)row * 1024 + c + 4) = x1 + gv[bj][1] * acc[ai][bj][m][1]; }
    }
};
struct EpiPlain {
    static constexpr bool PERM = true, AFTER_DRAIN = false, MIDHOOK = false;
    bf16_t* O; int ldc;
    __device__ __forceinline__ void operator()(const f32x4 (&acc)[2][2][4][2], const Unit& u, int wr, int wc, int fr, int fq) const {
        EPI_HEAD
        EPI_LOOP { const int row = row0 + ai * 128 + m * 16, c = col0 + bj * 128;
            *(u32x4*)(O + (size_t)row * ldc + c) = pack8(acc[ai][bj][m][0], acc[ai][bj][m][1]); }
    }
};

__device__ __forceinline__ void tr_item(const float* W, int ldw, int k0s, int n0s, bf16_t* WT, int dpitch, int k0d, int n0d, LAS float* scr, int lane) {
    f32x4 t[8];
#pragma unroll
    for (int i = 0; i < 8; ++i) { const int kk = (lane >> 3) + 8 * i; t[i] = *(const f32x4*)(W + (size_t)(k0s + kk) * ldw + n0s + (lane & 7) * 4); }
#pragma unroll
    for (int i = 0; i < 8; ++i) { const int kk = (lane >> 3) + 8 * i; LAS float* q = scr + kk * 33 + (lane & 7) * 4; q[0] = t[i][0]; q[1] = t[i][1]; q[2] = t[i][2]; q[3] = t[i][3]; }
    LDS_WAIT();
    const int c = lane & 7;
#pragma unroll
    for (int j = 0; j < 4; ++j) { const int n = (lane >> 3) + 8 * j; const LAS float* s = scr + (8 * c) * 33 + n;
        u32x4 o; o.x = cvt_pk_bf16(s[0 * 33], s[1 * 33]); o.y = cvt_pk_bf16(s[2 * 33], s[3 * 33]); o.z = cvt_pk_bf16(s[4 * 33], s[5 * 33]); o.w = cvt_pk_bf16(s[6 * 33], s[7 * 33]);
        *(u32x4*)(WT + (size_t)(n0d + n) * dpitch + k0d + 8 * c) = o; }
    LDS_WAIT();
}
__device__ __forceinline__ bool tr_job(int& r, const float* W, int ldw, int ks, int ns, int nK, int nN, bf16_t* WT, int dp, int nd0, LAS float* scr, int lane, int kd0 = 0, bool gate_il = false) {
    const int nb = nN / 32, items = (nK / 64) * nb;
    if (r < items) { const int kb = r / nb, nbi = r % nb; int nd = nd0 + 32 * nbi;
        if (gate_il && nd >= 1536) { const int cp = nd - 1536, half = cp >> 10, j = cp & 1023; nd = 1536 + 256 * (j >> 7) + 128 * half + (j & 127); }
        tr_item(W, ldw, ks + 64 * kb, ns + 32 * nbi, WT, dp, kd0 + 64 * kb, nd, scr, lane); return true; }
    r -= items; return false;
}

struct P0Args { const float *c, *cctx, *wada, *bada, *w_in, *w_glu, *w_pa, *w_pb, *w_out, *w_up, *w_down, *sgu_w;
                const float *a_re, *a_im, *logstep, *b_re, *b_im, *c_re, *c_im, *dskip; };

__device__ __forceinline__ void p0_gemv_item(int it, const P0Args& A, float* mod, LAS unsigned char* lds, int tid, int lane, int wave) {
    LAS float* sv = (LAS float*)(lds); LAS float* red = (LAS float*)(lds + 24576);
    for (int i = tid; i < 5 * 1024; i += NTHR) { const int r = i >> 10, k = i & 1023; const float v = r < 4 ? A.c[r * 1024 + k] : A.cctx[k]; sv[i] = v / (1.f + expf(-v)); }
    __syncthreads();
    const int n = it * 64 + lane, k0 = wave * 128;
    float a0 = 0.f, a1 = 0.f, a2 = 0.f, a3 = 0.f, a4 = 0.f;
#pragma unroll 32
    for (int kk = 0; kk < 128; ++kk) { const float w = A.wada[(size_t)(k0 + kk) * NMOD + n];
        a0 += sv[k0 + kk] * w; a1 += sv[1024 + k0 + kk] * w; a2 += sv[2048 + k0 + kk] * w; a3 += sv[3072 + k0 + kk] * w; a4 += sv[4096 + k0 + kk] * w; }
    red[(wave * 5 + 0) * 64 + lane] = a0; red[(wave * 5 + 1) * 64 + lane] = a1; red[(wave * 5 + 2) * 64 + lane] = a2; red[(wave * 5 + 3) * 64 + lane] = a3; red[(wave * 5 + 4) * 64 + lane] = a4;
    __syncthreads();
    if (tid < 320) { const int r = tid >> 6, l = tid & 63; float s = 0.f;
#pragma unroll
        for (int w = 0; w < 8; ++w) s += red[(w * 5 + r) * 64 + l];
        mod[r * NMOD + it * 64 + l] = s + A.bada[it * 64 + l]; }
    __syncthreads();
}

__device__ __forceinline__ void p0_s5_item(int dg, const P0Args& A, bf16_t* pfrag, bf16_t* qfrag, bf16_t* tfrag, LAS unsigned char* lds, int tid) {
    const int d = dg >> 5, g = dg & 31;
    LAS float* apr = (LAS float*)lds;
    LAS float* api = apr + 17 * 64;
    LAS float* bbr = api + 17 * 64;
    LAS float* bbi = bbr + 1024;
    LAS float* cr = bbi + 1024;
    LAS float* ci = cr + 1024;
    LAS float* T = ci + 1024;
    const float dt = expf(A.logstep[dg]);
    const float* are = A.a_re + dg * 64; const float* aim = A.a_im + dg * 64;
    for (int i = tid; i < 17 * 64; i += NTHR) { const int k = i >> 6, n = i & 63; const float kd = (float)k * dt; const float mag = expf(kd * are[n]); const float ang = kd * aim[n];
        apr[i] = mag * cosf(ang); api[i] = mag * sinf(ang); }
    for (int i = tid; i < 1024; i += NTHR) { cr[i] = A.c_re[dg * 1024 + i]; ci[i] = A.c_im[dg * 1024 + i]; }
    __syncthreads();
    for (int i = tid; i < 1024; i += NTHR) { const int n = i >> 4; const float ar = are[n], ai = aim[n]; const float p = apr[64 + n] - 1.f, q = api[64 + n]; const float den = ar * ar + ai * ai;
        const float kr = (p * ar + q * ai) / den, ki = (q * ar - p * ai) / den; const float br = A.b_re[dg * 1024 + i], bi = A.b_im[dg * 1024 + i];
        bbr[i] = kr * br - ki * bi; bbi[i] = kr * bi + ki * br; }
    __syncthreads();
    if (tid < 256) { const int lag = tid >> 4, ho = tid & 15; f32x4 s[4];
#pragma unroll
        for (int q = 0; q < 4; ++q) s[q] = (f32x4){0.f, 0.f, 0.f, 0.f};
        for (int n = 0; n < 64; ++n) { const float c_r = cr[ho * 64 + n], c_i = ci[ho * 64 + n], p_r = apr[lag * 64 + n], p_i = api[lag * 64 + n];
            const float qr = c_r * p_r - c_i * p_i, qi = c_r * p_i + c_i * p_r;
#pragma unroll
            for (int q = 0; q < 4; ++q) { const f32x4 b_r = *(const LAS f32x4*)(bbr + n * 16 + q * 4), b_i = *(const LAS f32x4*)(bbi + n * 16 + q * 4); s[q] += b_r * qr - b_i * qi; } }
#pragma unroll
        for (int q = 0; q < 4; ++q) *(LAS f32x4*)(T + tid * 16 + q * 4) = s[q];
        if (d == 0 && lag == 0) T[tid * 16 + ho] += A.dskip[g * 16 + ho]; }
    for (int f = tid; f < 4096; f += NTHR) { const int nt = f >> 9, ks = (f >> 6) & 7, ln = f & 63; const int col = nt * 16 + (ln & 15), kg = ln >> 4; const int jtok = ks * 2 + (kg >> 1), h0 = (kg & 1) * 8;
        const int n = col & 63, im = col >> 6; const int pw = d == 0 ? 15 - jtok : jtok; const float p_r = apr[pw * 64 + n], p_i = api[pw * 64 + n];
        float v[8];
#pragma unroll
        for (int e = 0; e < 8; ++e) { const float b_r = bbr[n * 16 + h0 + e], b_i = bbi[n * 16 + h0 + e]; v[e] = im ? (p_r * b_i + p_i * b_r) : (p_r * b_r - p_i * b_i); }
        u32x4 o; o.x = cvt_pk_bf16(v[0], v[1]); o.y = cvt_pk_bf16(v[2], v[3]); o.z = cvt_pk_bf16(v[4], v[5]); o.w = cvt_pk_bf16(v[6], v[7]);
        *(u32x4*)(pfrag + ((size_t)dg * 4096 + f) * 8) = o; }
    for (int f = tid; f < 4096; f += NTHR) { const int jout = f >> 8, ks = (f >> 6) & 3, ln = f & 63; const int ho = ln & 15, kg = ln >> 4; const int pw = d == 0 ? jout + 1 : 16 - jout;
        float v[8];
#pragma unroll
        for (int e = 0; e < 8; ++e) { const int kk = ks * 32 + kg * 8 + e, n = kk & 63, im = kk >> 6; const float c_r = cr[ho * 64 + n], c_i = ci[ho * 64 + n], p_r = apr[pw * 64 + n], p_i = api[pw * 64 + n];
            v[e] = im ? -(c_r * p_i + c_i * p_r) : (c_r * p_r - c_i * p_i); }
        u32x4 o; o.x = cvt_pk_bf16(v[0], v[1]); o.y = cvt_pk_bf16(v[2], v[3]); o.z = cvt_pk_bf16(v[4], v[5]); o.w = cvt_pk_bf16(v[6], v[7]);
        *(u32x4*)(qfrag + ((size_t)dg * 4096 + f) * 8) = o; }
    __syncthreads();
    for (int f = tid; f < 1024; f += NTHR) { const int dd = f >> 6, ln = f & 63; const int ho = ln & 15, kg = ln >> 4; const int lag = d == 0 ? dd - (kg >> 1) : dd - 1 + (kg >> 1); const int hi0 = (kg & 1) * 8;
        float v[8];
#pragma unroll
        for (int e = 0; e < 8; ++e) v[e] = lag >= 0 ? T[(lag & 15) * 256 + ho * 16 + hi0 + e] : 0.f;
        u32x4 o; o.x = cvt_pk_bf16(v[0], v[1]); o.y = cvt_pk_bf16(v[2], v[3]); o.z = cvt_pk_bf16(v[4], v[5]); o.w = cvt_pk_bf16(v[6], v[7]);
        *(u32x4*)(tfrag + ((size_t)dg * 1024 + f) * 8) = o; }
    __syncthreads();
}

__device__ __forceinline__ void mod_rows(const float* xs, const float* ctx, int nrows, const float* gamma, const float* mod, int shoff, int scoff, bf16_t* out, int gw, int NGW, int lane) {
    for (int mb = gw; mb < nrows; mb += 4 * NGW) {
        f32x4 v[4][4];
#pragma unroll
        for (int q = 0; q < 4; ++q) { const int m = (mb + q * NGW < nrows) ? mb + q * NGW : mb; const float* xr = (m < MTOK) ? xs + (size_t)m * DM : ctx + (size_t)(m - MTOK) * DM;
#pragma unroll
            for (int j = 0; j < 4; ++j) v[q][j] = ((const f32x4*)xr)[lane + 64 * j]; }
#pragma unroll
        for (int q = 0; q < 4; ++q) { const int m = mb + q * NGW; float s = 0.f;
#pragma unroll
            for (int j = 0; j < 4; ++j) s += (v[q][j][0] * v[q][j][0] + v[q][j][1] * v[q][j][1]) + (v[q][j][2] * v[q][j][2] + v[q][j][3] * v[q][j][3]);
            const float rstd = rsqrtf(wave_sum(s) * (1.f / DM) + EPS);
            if (m < nrows) { const int mr = (m < MTOK) ? (m >> 13) : 4;
#pragma unroll
                for (int j = 0; j < 4; ++j) { const int col = 4 * (lane + 64 * j);
                    const f32x4 g4 = *(const f32x4*)(gamma + col), sc4 = *(const f32x4*)(mod + mr * NMOD + scoff + col), sh4 = *(const f32x4*)(mod + mr * NMOD + shoff + col);
                    const f32x4 o = (v[q][j] * rstd) * g4 * (sc4 + 1.f) + sh4; u32x2 w; w.x = cvt_pk_bf16(o[0], o[1]); w.y = cvt_pk_bf16(o[2], o[3]); *(u32x2*)(out + (size_t)m * DM + col) = w; } } }
    }
}
__device__ __forceinline__ void mod_rows2(const float* xs, const float* ctx, int nrows, const float* gamma, const float* mod, int shoff, int scoff, bf16_t* out, int gw, int NGW, int lane) {
    for (int mb = gw; mb < nrows; mb += 4 * NGW) {
        f32x4 v[4][4];
#pragma unroll
        for (int q = 0; q < 4; ++q) { const int m = (mb + q * NGW < nrows) ? mb + q * NGW : mb; const float* xr = (m < MTOK) ? xs + (size_t)m * DM : ctx + (size_t)(m - MTOK) * DM;
#pragma unroll
            for (int j = 0; j < 4; ++j) v[q][j] = ((const f32x4*)xr)[lane + 64 * j]; }
#pragma unroll
        for (int q = 0; q < 4; ++q) { const int m = mb + q * NGW; float s = 0.f;
#pragma unroll
            for (int j = 0; j < 4; ++j) s += (v[q][j][0] * v[q][j][0] + v[q][j][1] * v[q][j][1]) + (v[q][j][2] * v[q][j][2] + v[q][j][3] * v[q][j][3]);
            const float rstd = rsqrtf(wave_sum(s) * (1.f / DM) + EPS);
            if (m < nrows) { const int mr = (m < MTOK) ? (m >> 13) : 4;
#pragma unroll
                for (int j = 0; j < 4; ++j) { const int col = 4 * (lane + 64 * j);
                    const f32x4 g4 = *(const f32x4*)(gamma + col), sc4 = *(const f32x4*)(mod + mr * NMOD + scoff + col), sh4 = *(const f32x4*)(mod + mr * NMOD + shoff + col);
                    const f32x4 o = (v[q][j] * rstd) * g4 * (sc4 + 1.f) + sh4; u32x2 w; w.x = cvt_pk_bf16(o[0], o[1]); w.y = cvt_pk_bf16(o[2], o[3]); *(u32x2*)(out + (size_t)m * DM + col) = w; } } }
    }
}

constexpr int UCTX_OFF = 65536 + 16896;
#define CMULADD(hr, hi, ar, ai, sr, si) do { const float _nr = (ar) * (hr) - (ai) * (hi) + (sr), _ni = (ar) * (hi) + (ai) * (hr) + (si); (hr) = _nr; (hi) = _ni; } while (0)
__device__ __forceinline__ void s5_load_act(bf16x8 (&act)[8], int mt, LAS unsigned char* lds, const bf16_t* useq, int lane) {
    const int chunk = mt * 16 + (lane & 15), fq = lane >> 4;
    if (mt == 0) {
#pragma unroll
        for (int ks = 0; ks < 8; ++ks) act[ks] = *(const LAS bf16x8*)(lds + UCTX_OFF + (chunk * 256 + ks * 32 + fq * 8) * 2);
    } else if (mt > 0) {
#pragma unroll
        for (int ks = 0; ks < 8; ++ks) act[ks] = *(const bf16x8*)(useq + (size_t)chunk * 256 + ks * 32 + fq * 8);
    }
}
template <bool WRITE>
__device__ __forceinline__ void s5_tile(const bf16x8 (&act)[8], int mt, int d, LAS unsigned char* lds, bf16_t* hp, const float (&a16r)[4], const float (&a16i)[4], const float (&A4r)[4], const float (&A4i)[4],
                                        float (&Hr)[4], float (&Hi)[4], int lane) {
    const int n16 = lane & 15, fq = lane >> 4;
    const int qpos = d ? 3 - fq : fq;
#pragma unroll
    for (int t = 0; t < 4; ++t) {
        f32x4 are = {0.f, 0.f, 0.f, 0.f}, aim = {0.f, 0.f, 0.f, 0.f};
#pragma unroll
        for (int ks = 0; ks < 8; ++ks) { are = MFMA16(act[ks], *(const LAS bf16x8*)(lds + ((t * 8 + ks) * 64 + lane) * 16), are);
                                         aim = MFMA16(act[ks], *(const LAS bf16x8*)(lds + (((t + 4) * 8 + ks) * 64 + lane) * 16), aim); }
        float sr[4], si[4];
#pragma unroll
        for (int k = 0; k < 4; ++k) { sr[k] = d ? are[3 - k] : are[k]; si[k] = d ? aim[3 - k] : aim[k]; }
        float gr = 0.f, gi = 0.f;
#pragma unroll
        for (int k = 0; k < 4; ++k) CMULADD(gr, gi, a16r[t], a16i[t], sr[k], si[k]);
        float run_r = Hr[t], run_i = Hi[t], my_r = 0.f, my_i = 0.f;
#pragma unroll
        for (int pos = 0; pos < 4; ++pos) { const int p = d ? 3 - pos : pos; const float pr = __shfl(gr, n16 + 16 * p), pi = __shfl(gi, n16 + 16 * p);
            if (pos == qpos) { my_r = run_r; my_i = run_i; }
            CMULADD(run_r, run_i, A4r[t], A4i[t], pr, pi); }
        Hr[t] = run_r; Hi[t] = run_i;
        if (WRITE) {
            float h_r = my_r, h_i = my_i; const int n = t * 16 + n16;
#pragma unroll
            for (int k = 0; k < 4; ++k) { const int cc = mt * 16 + fq * 4 + (d ? 3 - k : k);
                hp[(size_t)cc * 128 + n] = f2bf(h_r); hp[(size_t)cc * 128 + 64 + n] = f2bf(h_i);
                CMULADD(h_r, h_i, a16r[t], a16i[t], sr[k], si[k]); }
        }
    }
}

__device__ __forceinline__ void s5ab_item(int item, LAS unsigned char* lds, const bf16_t* pfrag, const bf16_t* ug, const bf16_t* hbuf, const bf16_t* win, bf16_t* hprev,
                                          const float* a_re, const float* a_im, const float* logstep, int tid, int lane, int wave) {
    const int d = item >> 7, b = (item >> 5) & 3, g = item & 31, dg = d * 32 + g;
    { const u32x4* src = (const u32x4*)(pfrag + (size_t)dg * 32768);
      for (int i = tid; i < 4096; i += NTHR) ((LAS u32x4*)lds)[i] = src[i]; }
    const bf16_t* useq = ug + (size_t)(b * 32 + g) * LTOT * 16;
    bf16_t* hp = hprev + (size_t)item * NCH * 128;
    LAS float* TT = (LAS float*)(lds + 65536);
    float a16r[4], a16i[4], A4r[4], A4i[4], ATr[4], ATi[4];
    { const float dt = expf(logstep[dg]);
#pragma unroll
      for (int t = 0; t < 4; ++t) { const int n = t * 16 + (lane & 15); const float k16 = 16.f * dt; const float mag = expf(k16 * a_re[dg * 64 + n]); const float ang = k16 * a_im[dg * 64 + n];
          const float r1 = mag * cosf(ang), i1 = mag * sinf(ang); a16r[t] = r1; a16i[t] = i1;
          const float r2 = r1 * r1 - i1 * i1, i2 = 2.f * r1 * i1; const float r4 = r2 * r2 - i2 * i2, i4 = 2.f * r2 * i2; A4r[t] = r4; A4i[t] = i4;
          const float r8 = r4 * r4 - i4 * i4, i8 = 2.f * r4 * i4; ATr[t] = r8 * r8 - i8 * i8; ATi[t] = 2.f * r8 * i8; } }
    for (int mtc = wave; mtc < 16; mtc += 8) {
        const bf16_t* ap = hbuf + ((size_t)(MTOK + b * 256 + mtc * 16 + (lane & 15))) * 1024 + (lane >> 4) * 8;
        const bf16_t* bp = win + ((size_t)(g * 16 + (lane & 15))) * 1024 + (lane >> 4) * 8;
        f32x4 acc = {0.f, 0.f, 0.f, 0.f};
#pragma unroll 16
        for (int ks = 0; ks < 32; ++ks) acc = MFMA16(*(const bf16x8*)(ap + ks * 32), *(const bf16x8*)(bp + ks * 32), acc);
        LAS bf16_t* uc = (LAS bf16_t*)(lds + UCTX_OFF);
#pragma unroll
        for (int r = 0; r < 4; ++r) uc[(mtc * 16 + (lane >> 4) * 4 + r) * 16 + (lane & 15)] = f2bf(acc[r]);
    }
    __syncthreads();
#define S5_NTH(k) (d == 0 ? ((wave + 8 * (k)) < NCH / 16 ? wave + 8 * (k) : -1) : (wave == 0 ? ((k) == 0 ? 0 : ((k) <= 4 ? 40 - 8 * (k) : -1)) : ((k) <= 3 ? 24 + wave - 8 * (k) : -1)))
    { bf16x8 actA[8], actB[8]; int mt = S5_NTH(0); s5_load_act(actA, mt, lds, useq, lane);
      for (int k = 0; mt >= 0; ++k) { const int nx = S5_NTH(k + 1); s5_load_act(actB, nx, lds, useq, lane);
        float Hr[4] = {0.f, 0.f, 0.f, 0.f}, Hi[4] = {0.f, 0.f, 0.f, 0.f};
        s5_tile<false>(actA, mt, d, lds, hp, a16r, a16i, A4r, A4i, Hr, Hi, lane);
        if (lane < 16) {
#pragma unroll
            for (int t = 0; t < 4; ++t) { TT[(mt * 64 + t * 16 + lane) * 2] = Hr[t]; TT[(mt * 64 + t * 16 + lane) * 2 + 1] = Hi[t]; } }
#pragma unroll
        for (int ks = 0; ks < 8; ++ks) actA[ks] = actB[ks];
        mt = nx; } }
    __syncthreads();
    { float Hr[4] = {0.f, 0.f, 0.f, 0.f}, Hi[4] = {0.f, 0.f, 0.f, 0.f};
      bf16x8 actA[8]; int k = 0, mine = S5_NTH(0); s5_load_act(actA, mine, lds, useq, lane);
      for (int idx = 0; idx < NCH / 16; ++idx) { const int mt = d ? (idx == 0 ? 0 : NCH / 16 - idx) : idx;
          if (mt == mine) { float Tr[4], Ti[4];
#pragma unroll
              for (int t = 0; t < 4; ++t) { Tr[t] = Hr[t]; Ti[t] = Hi[t]; }
              bf16x8 actB[8]; ++k; const int nx = S5_NTH(k); s5_load_act(actB, nx, lds, useq, lane);
              s5_tile<true>(actA, mt, d, lds, hp, a16r, a16i, A4r, A4i, Tr, Ti, lane);
#pragma unroll
              for (int ks = 0; ks < 8; ++ks) actA[ks] = actB[ks];
              mine = nx; }
#pragma unroll
          for (int t = 0; t < 4; ++t) { const float sr = TT[(mt * 64 + t * 16 + (lane & 15)) * 2], si = TT[(mt * 64 + t * 16 + (lane & 15)) * 2 + 1]; CMULADD(Hr[t], Hi[t], ATr[t], ATi[t], sr, si); } } }
#undef S5_NTH
    __syncthreads();
}

constexpr int VTP = 136;
__device__ __forceinline__ void sgu_item(int chunk, LAS unsigned char* lds, const bf16_t* zb, const bf16_t* sguw16, const float* sgub, const float* lng, const float* lnb, bf16_t* yb, int tid, int lane, int wave) {
    LAS bf16_t* vT = (LAS bf16_t*)lds;
    float gl[8], bl[8];
#pragma unroll
    for (int e = 0; e < 8; ++e) { gl[e] = lng[lane + 64 * e]; bl[e] = lnb[lane + 64 * e]; }
    for (int ib = 0; ib < 16; ib += 4) {
        float v[4][8];
#pragma unroll
        for (int q = 0; q < 4; ++q) { const bf16_t* zr = zb + (size_t)(chunk * 128 + wave * 16 + ib + q) * 1024 + 512;
#pragma unroll
            for (int e = 0; e < 8; ++e) v[q][e] = bf2f(zr[lane + 64 * e]); }
#pragma unroll
        for (int q = 0; q < 4; ++q) { const int p = wave * 16 + ib + q; float s = 0.f;
#pragma unroll
            for (int e = 0; e < 8; ++e) s += v[q][e];
            const float mean = wave_sum(s) * (1.f / 512.f); float s2 = 0.f;
#pragma unroll
            for (int e = 0; e < 8; ++e) { v[q][e] -= mean; s2 += v[q][e] * v[q][e]; }
            const float rstd = rsqrtf(wave_sum(s2) * (1.f / 512.f) + EPS);
#pragma unroll
            for (int e = 0; e < 8; ++e) vT[(lane + 64 * e) * VTP + p] = f2bf(v[q][e] * rstd * gl[e] + bl[e]); }
    }
    __syncthreads();
    const int gg = wave, i_ = lane & 15, kg = lane >> 4;
    bf16x8 vf[4][4];
#pragma unroll
    for (int dt = 0; dt < 4; ++dt)
#pragma unroll
        for (int ks = 0; ks < 4; ++ks) vf[dt][ks] = *(const LAS bf16x8*)(vT + (gg * 64 + dt * 16 + i_) * VTP + ks * 32 + kg * 8);
    bf16x8 wf[4];
#pragma unroll
    for (int ks = 0; ks < 4; ++ks) wf[ks] = *(const bf16x8*)(sguw16 + ((size_t)(gg * 128 + i_)) * 128 + ks * 32 + kg * 8);
    for (int qt = 0; qt < 8; ++qt) { const int q = qt * 16 + i_; const size_t row = (size_t)chunk * 128 + q;
        bf16x8 wn[4]; u32x2 uz[4];
#pragma unroll
        for (int ks = 0; ks < 4; ++ks) wn[ks] = *(const bf16x8*)(sguw16 + ((size_t)(gg * 128 + ((qt + 1) & 7) * 16 + i_)) * 128 + ks * 32 + kg * 8);
#pragma unroll
        for (int dt = 0; dt < 4; ++dt) uz[dt] = *(const u32x2*)(zb + row * 1024 + gg * 64 + dt * 16 + kg * 4);
        const float bias = sgub[gg * 128 + q];
        f32x4 acc[4];
#pragma unroll
        for (int dt = 0; dt < 4; ++dt) { acc[dt] = (f32x4){0.f, 0.f, 0.f, 0.f};
#pragma unroll
            for (int ks = 0; ks < 4; ++ks) acc[dt] = MFMA16(vf[dt][ks], wf[ks], acc[dt]); }
#pragma unroll
        for (int dt = 0; dt < 4; ++dt) { const int c = gg * 64 + dt * 16 + kg * 4;
            u32x2 w; w.x = cvt_pk_bf16(bflo(uz[dt].x) * (acc[dt][0] + bias), bfhi(uz[dt].x) * (acc[dt][1] + bias)); w.y = cvt_pk_bf16(bflo(uz[dt].y) * (acc[dt][2] + bias), bfhi(uz[dt].y) * (acc[dt][3] + bias));
            *(u32x2*)(yb + row * 1024 + c) = w; }
#pragma unroll
        for (int ks = 0; ks < 4; ++ks) wf[ks] = wn[ks];
    }
    __syncthreads();
}

__device__ __forceinline__ void s5c_item(int item, LAS unsigned char* lds, const bf16_t* qfrag, const bf16_t* tfrag, const bf16_t* ug, const bf16_t* hprev, bf16_t* gy, int tid, int lane, int wave) {
    const int b = item >> 7, g = (item >> 2) & 31, quarter = item & 3;
    const bf16_t* useq = ug + (size_t)(b * 32 + g) * LTOT * 16;
    const int kg = lane >> 4;
    const int chunk = 16 + (quarter * 8 + wave) * 16 + (lane & 15);
    bf16x8 U[8];
#pragma unroll
    for (int ks = 0; ks < 8; ++ks) U[ks] = *(const bf16x8*)(useq + (size_t)chunk * 256 + ks * 32 + kg * 8);
    f32x4 acc[16];
#pragma unroll
    for (int j = 0; j < 16; ++j) acc[j] = (f32x4){0.f, 0.f, 0.f, 0.f};
#pragma unroll
    for (int d = 0; d < 2; ++d) {
        __syncthreads();
        { const u32x4* src = (const u32x4*)(qfrag + (size_t)(d * 32 + g) * 32768);
          for (int i = tid; i < 4096; i += NTHR) ((LAS u32x4*)lds)[i] = src[i];
          const u32x4* srt = (const u32x4*)(tfrag + (size_t)(d * 32 + g) * 8192);
          for (int i = tid; i < 1024; i += NTHR) ((LAS u32x4*)(lds + 65536))[i] = srt[i]; }
        const bf16_t* hp = hprev + ((size_t)((d * 4 + b) * 32 + g) * NCH + chunk) * 128;
        bf16x8 H[4];
#pragma unroll
        for (int ks = 0; ks < 4; ++ks) H[ks] = *(const bf16x8*)(hp + ks * 32 + kg * 8);
        __syncthreads();
#pragma unroll
        for (int jout = 0; jout < 16; ++jout) {
#pragma unroll
            for (int ks = 0; ks < 4; ++ks) acc[jout] = MFMA16(*(const LAS bf16x8*)(lds + ((jout * 4 + ks) * 64 + lane) * 16), H[ks], acc[jout]);
            if (d == 0) {
#pragma unroll
                for (int ks = 0; ks < 8; ++ks) if (2 * ks <= jout) acc[jout] = MFMA16(*(const LAS bf16x8*)(lds + 65536 + ((jout - 2 * ks) * 64 + lane) * 16), U[ks], acc[jout]);
            } else {
#pragma unroll
                for (int ks = 0; ks < 8; ++ks) if (2 * ks + 1 >= jout) acc[jout] = MFMA16(*(const LAS bf16x8*)(lds + 65536 + ((2 * ks - jout + 1) * 64 + lane) * 16), U[ks], acc[jout]);
            }
        }
    }
    const size_t rowb = (size_t)b * SEQ + (size_t)(chunk - 16) * 16; const int c = g * 16 + kg * 4;
#pragma unroll
    for (int jout = 0; jout < 16; ++jout) { u32x2 w; w.x = cvt_pk_bf16(gelu_t(acc[jout][0]), gelu_t(acc[jout][1])); w.y = cvt_pk_bf16(gelu_t(acc[jout][2]), gelu_t(acc[jout][3]));
        *(u32x2*)(gy + (rowb + jout) * 512 + c) = w; }
    __syncthreads();
}

struct CRow { f32x4 g[3], v[3]; };
__device__ __forceinline__ f32x4 unpack4(unsigned x, unsigned y) { return (f32x4){bflo(x), bfhi(x), bflo(y), bfhi(y)}; }
__device__ __forceinline__ u32x4 conv_load(const bf16_t* p, int rowstride, int J, int rr) {
    u32x4 R = {0u, 0u, 0u, 0u};
    if (p != nullptr && rr >= 0 && rr < 128) { const size_t off = (size_t)rr * rowstride; const u32x2 g = *(const u32x2*)(p + off), v = *(const u32x2*)(p + off + J); R = (u32x4){g.x, g.y, v.x, v.y}; }
    return R;
}
__device__ __forceinline__ void conv_acc(f32x4& ag, f32x4& av, const CRow& R, const f32x4 (&wg)[9], const f32x4 (&wv)[9], int kh) {
#pragma unroll
    for (int k = 0; k < 3; ++k) { ag += wg[kh * 3 + k] * R.g[k]; av += wv[kh * 3 + k] * R.v[k]; }
}
#define CONV_STEP(FP, FC, FN, PUN, PLD, HUN, HLD, SLOT, r) do { if ((r) < rend) { \
        const int rl_ = ((r) + 4 <= rend) ? (r) + 4 : 1000; PLD = conv_load(pC, rowstride, J, rl_); HLD = conv_load(pH, rowstride, J, rl_); \
        xl[(SLOT) * 640 + (w + 1) * 64 + cgp] = PUN; if (pHslot >= 0) xl[(SLOT) * 640 + pHslot * 64 + cgp] = HUN; \
        if ((r) >= r0) { f32x4 ag = bg, av = bv; conv_acc(ag, av, FP, wg, wv, 0); conv_acc(ag, av, FC, wg, wv, 1); conv_acc(ag, av, FN, wg, wv, 2); \
            u32x2 w_; w_.x = cvt_pk_bf16(ag[0] * sigm(ag[0]) * av[0], ag[1] * sigm(ag[1]) * av[1]); w_.y = cvt_pk_bf16(ag[2] * sigm(ag[2]) * av[2], ag[3] * sigm(ag[3]) * av[3]); \
            *(u32x2*)(ap + (size_t)(r) * 64 * FFH) = w_; } \
        asm volatile("s_waitcnt lgkmcnt(0)" ::: "memory"); __builtin_amdgcn_s_barrier(); asm volatile("" ::: "memory"); \
        { const u32x4 nl_ = xl[(SLOT) * 640 + w * 64 + cgp], nr_ = xl[(SLOT) * 640 + (w + 2) * 64 + cgp]; const u32x4 own_ = PUN; \
          FP.g[0] = unpack4(nl_.x, nl_.y); FP.v[0] = unpack4(nl_.z, nl_.w); FP.g[1] = unpack4(own_.x, own_.y); FP.v[1] = unpack4(own_.z, own_.w); FP.g[2] = unpack4(nr_.x, nr_.y); FP.v[2] = unpack4(nr_.z, nr_.w); } } } while (0)
__device__ __forceinline__ void conv_phase(const bf16_t* up, int J, int j0, const float* convw, const float* convb, bf16_t* act, LAS unsigned char* lds, int bid, int G, int tid) {
    const int ldu = 2 * J, nslab = J / 256, nitems = 4 * 8 * 8 * nslab, rowstride = 64 * ldu;
    LAS u32x4* xl = (LAS u32x4*)lds;
    const int cgp = tid & 63, w = tid >> 6;
    for (int it = bid; it < nitems; it += G) {
        const int slab = it % nslab; int t = it / nslab; const int cg8 = t & 7; t >>= 3; const int band = t & 7, b = t >> 3;
        const int col = cg8 * 8 + w, jg = slab * 256 + cgp * 4;
        f32x4 wg[9], wv[9];
#pragma unroll
        for (int k = 0; k < 9; ++k) { wg[k] = *(const f32x4*)(convw + k * F2 + j0 + jg); wv[k] = *(const f32x4*)(convw + k * F2 + FFH + j0 + jg); }
        const f32x4 bg = *(const f32x4*)(convb + j0 + jg), bv = *(const f32x4*)(convb + FFH + j0 + jg);
        const bf16_t* pC = up + ((size_t)b * SEQ + col) * ldu + jg;
        const int pHslot = (w == 0) ? 0 : ((w == 7) ? 9 : -1);
        const bf16_t* pH = (w == 0) ? (col > 0 ? pC - ldu : nullptr) : ((w == 7) ? (col < 63 ? pC + ldu : nullptr) : nullptr);
        bf16_t* ap = act + ((size_t)b * SEQ + col) * FFH + j0 + jg;
        const int r0 = band * 16, rend = r0 + 16;
        CRow F0, F1, F2; u32x4 P0, P1, P2, H0, H1, H2;
#pragma unroll
        for (int k = 0; k < 3; ++k) { F0.g[k] = F0.v[k] = F1.g[k] = F1.v[k] = F2.g[k] = F2.v[k] = (f32x4){0.f, 0.f, 0.f, 0.f}; }
        P0 = conv_load(pC, rowstride, J, r0 - 1); H0 = conv_load(pH, rowstride, J, r0 - 1); P1 = conv_load(pC, rowstride, J, r0); H1 = conv_load(pH, rowstride, J, r0); P2 = P1; H2 = H1;
        __syncthreads();
        for (int r = r0 - 3; r < rend; r += 3) {
            CONV_STEP(F0, F1, F2, P0, P2, H0, H2, 0, r);
            CONV_STEP(F1, F2, F0, P1, P0, H1, H0, 1, r + 1);
            CONV_STEP(F2, F0, F1, P2, P1, H2, H1, 2, r + 2);
        }
    }
    __syncthreads();
}

#define XB_TMO      128
#define XB_XCNT(j)  (256  + 64 * (j))
#define XB_XSUB(j)  (1280 + 64 * (j))
#define XB_XGEN(j)  (2304 + 64 * (j))
#define XB_TOP      3328
#define XB_TOPGEN   3392
#define XCD_BAR_WORDS 3456
#define XB_SPIN_CAP (1u << 18)
__device__ __forceinline__ unsigned xb_ld(unsigned* p)              { return __hip_atomic_load(p, __ATOMIC_RELAXED, __HIP_MEMORY_SCOPE_AGENT); }
__device__ __forceinline__ unsigned xb_add(unsigned* p, unsigned v) { return __hip_atomic_fetch_add(p, v, __ATOMIC_RELAXED, __HIP_MEMORY_SCOPE_AGENT); }
__device__ __forceinline__ unsigned xb_xcc_id() { return (unsigned)__builtin_amdgcn_s_getreg((3 << 11) | 20) & 0xFu; }
#define XB_SPIN(cond, bar) do { unsigned _sp = 0; while (cond) { __builtin_amdgcn_s_sleep(1); \
    if ((++_sp & 255u) == 0u) { if (xb_ld(&(bar)[XB_TMO])) break; if (_sp > XB_SPIN_CAP) { atomicAdd(&(bar)[XB_TMO], 1u); break; } } } } while (0)
struct XcdBarrier { unsigned* bar; unsigned x; volatile LAS unsigned* st; };
__device__ __forceinline__ XcdBarrier xcd_barrier_post(unsigned* bar, volatile LAS unsigned* st) {
    XcdBarrier b; b.bar = bar; b.x = xb_xcc_id(); b.st = st;
    if (threadIdx.x == 0) (void)xb_add(&bar[XB_XCNT(b.x)], 1u);
    return b;
}
__device__ __forceinline__ void xcd_barrier_complete(unsigned* bar, unsigned x, unsigned& nloc, unsigned& nx) {
    const unsigned G = gridDim.x * gridDim.y * gridDim.z;
    unsigned sum, cnt, mine, sp = 0u;
    for (;;) {
        sum = 0u; cnt = 0u; mine = 0u;
#pragma unroll
        for (unsigned j = 0; j < 16; ++j) { const unsigned c = xb_ld(&bar[XB_XCNT(j)]); sum += c; cnt += (c > 0u) ? 1u : 0u; mine = (j == x) ? c : mine; }
        if (sum == G) break;
        __builtin_amdgcn_s_sleep(1);
        if ((++sp & 255u) == 0u) { if (xb_ld(&bar[XB_TMO])) break; if (sp > XB_SPIN_CAP) { atomicAdd(&bar[XB_TMO], 1u); break; } }
    }
    nloc = mine > 0u ? mine : 1u; nx = cnt > 0u ? cnt : 1u;
}
__device__ __forceinline__ void xcd_barrier(const XcdBarrier& b) {
    asm volatile("s_waitcnt vmcnt(0)" ::: "memory");
    __syncthreads();
    if (threadIdx.x == 0) {
        unsigned* bar = b.bar;
        __builtin_amdgcn_s_waitcnt(0);
        unsigned nloc = b.st[0], nx = b.st[1];
        if (nloc == 0u) { xcd_barrier_complete(bar, b.x, nloc, nx); b.st[0] = nloc; b.st[1] = nx; }
        const unsigned old = xb_add(&bar[XB_XSUB(b.x)], 1u);
        const unsigned gen = old / nloc;
        if (old + 1u == (gen + 1u) * nloc) {
            __builtin_amdgcn_fence(__ATOMIC_RELEASE, "agent");
            asm volatile("s_waitcnt vmcnt(0)" ::: "memory");
            const unsigned og = xb_add(&bar[XB_TOP], 1u);
            const unsigned tg = og / nx;
            if (og + 1u == (tg + 1u) * nx) xb_add(&bar[XB_TOPGEN], 1u);
            else XB_SPIN(xb_ld(&bar[XB_TOPGEN]) == tg, bar);
            __builtin_amdgcn_fence(__ATOMIC_ACQUIRE, "agent");
            xb_add(&bar[XB_XGEN(b.x)], 1u);
            asm volatile("s_waitcnt vmcnt(0)" ::: "memory");
        } else {
            XB_SPIN(xb_ld(&bar[XB_XGEN(b.x)]) == gen, bar);
            __builtin_amdgcn_fence(__ATOMIC_ACQUIRE, "agent");
            asm volatile("s_waitcnt vmcnt(0)" ::: "memory");
        }
    }
    __syncthreads();
}

constexpr int NPHASE = 15;
struct Args { const float* in[32]; float* out; unsigned char* ws; int ph_lo, ph_hi; };

__global__ void __launch_bounds__(NTHR, 2) fwd_kernel(Args a) {
    extern __shared__ __attribute__((aligned(16))) unsigned char lds_raw[];
    LAS unsigned char* lds = (LAS unsigned char*)lds_raw;
    cg::grid_group grid = cg::this_grid();
    const int tid = threadIdx.x, lane = tid & 63, wave = __builtin_amdgcn_readfirstlane(tid >> 6);
    const int G = gridDim.x, bid = blockIdx.x, gw = bid * 8 + wave, NGW = G * 8;
    unsigned char* ws = a.ws;
    const int lo = a.ph_lo, hi = a.ph_hi;
#define IN(k) (lo <= (k) && (k) < hi)
#ifndef PHMASK
#define PHMASK 0x7fff
#endif
#define PHON(k) ((PHMASK >> (k)) & 1)
#ifndef REPMASK
#define REPMASK 0
#endif
#define NREP(k) (1 + ((REPMASK >> (k)) & 1))
#define SEAM(k) do { if (IN(k) && IN((k) + 1)) xcd_barrier(xbar); } while (0)
    if (tid < 16) ((LAS unsigned*)(lds + LDS_BYTES - 64))[tid] = 0u;
    __syncthreads();
    if (a.ph_lo < 0) grid.sync();
    const XcdBarrier xbar = xcd_barrier_post((unsigned*)(ws + WS_BAR), (volatile LAS unsigned*)(lds + LDS_BYTES - 64));
#define DUMPG(k) do { } while (0)
#if defined(DBG_TS)
    unsigned long long ts_a = 0, ts_b = 0;
    if (DBG_TS == 0) ts_a = __builtin_amdgcn_s_memrealtime();
#define TSTAMP(k) do { if ((k) + 1 == DBG_TS || ((k) == 2 && DBG_TS == 103)) ts_a = __builtin_amdgcn_s_memrealtime(); if ((k) == DBG_TS) ts_b = __builtin_amdgcn_s_memrealtime(); } while (0)
#elif defined(DBG_TSEAM)
    unsigned long long ts_a = 0, ts_b = 0;
#define TSTAMP(k) do { if ((k) == DBG_TSEAM) ts_b = __builtin_amdgcn_s_memrealtime(); } while (0)
#define TSPRE(k) do { if ((k) == DBG_TSEAM) ts_a = __builtin_amdgcn_s_memrealtime(); } while (0)
#else
#define TSTAMP(k) do { } while (0)
#endif
#ifndef TSPRE
#define TSPRE(k) do { } while (0)
#endif
    float* mod = (float*)(ws + WS_MOD);
    bf16_t* hbuf = (bf16_t*)(ws + WS_HBUF);
    using pg8::Gemm; using pg8::gemm_phase;

    P0Args A;
    { A.c = a.in[1]; A.cctx = a.in[3]; A.wada = a.in[4]; A.bada = a.in[5]; A.w_in = a.in[7]; A.w_glu = a.in[16]; A.w_pa = a.in[22]; A.w_pb = a.in[23]; A.w_out = a.in[25];
        A.w_up = a.in[27]; A.w_down = a.in[30]; A.sgu_w = a.in[20]; A.a_re = a.in[8]; A.a_im = a.in[9]; A.logstep = a.in[10]; A.b_re = a.in[11]; A.b_im = a.in[12]; A.c_re = a.in[13]; A.c_im = a.in[14]; A.dskip = a.in[15]; }
    if (PHON(0) && IN(0)) for (int _r = 0; _r < NREP(0); ++_r) {
        for (int it = bid; it < 96 + 64; it += G) {
            if (it < 96) p0_gemv_item(it, A, mod, lds, tid, lane, wave);
            else p0_s5_item(it - 96, A, (bf16_t*)(ws + WS_PFRAG), (bf16_t*)(ws + WS_QFRAG), (bf16_t*)(ws + WS_TFRAG), lds, tid);
        }
        __syncthreads();
        LAS float* scr = (LAS float*)(lds + wave * 16384);
        constexpr int NIT = 1792 + 128 + 256 + 256 + 512 + 2816 + 1408 + 256;
        const bool trall = G < 224;
        for (int it = trall ? gw : (bid - 160) * 8 + wave; it < NIT && (trall || bid >= 160); it += trall ? NGW : (G - 160) * 8) { int r = it;
            if (tr_job(r, A.w_in, 3584, 0, 0, 1024, 3584, (bf16_t*)(ws + WS_WIN), 1024, 0, scr, lane, 0, true)) continue;
            if (tr_job(r, A.w_glu, 512, 0, 0, 512, 512, (bf16_t*)(ws + WS_WGLU), 512, 0, scr, lane)) continue;
            if (tr_job(r, A.w_pa, 1024, 0, 0, 512, 1024, (bf16_t*)(ws + WS_WPA), 1024, 0, scr, lane, 0)) continue;
            if (tr_job(r, A.w_pb, 1024, 0, 0, 512, 1024, (bf16_t*)(ws + WS_WPA), 1024, 0, scr, lane, 512)) continue;
            if (tr_job(r, A.w_out, 1024, 0, 0, 1024, 1024, (bf16_t*)(ws + WS_WOUT), 1024, 0, scr, lane)) continue;
            if (tr_job(r, A.w_up, F2, 0, 0, 1024, J1, (bf16_t*)(ws + WS_WUP1), 1024, 0, scr, lane)) continue;
            if (tr_job(r, A.w_up, F2, 0, FFH, 1024, J1, (bf16_t*)(ws + WS_WUP1), 1024, J1, scr, lane)) continue;
            if (tr_job(r, A.w_up, F2, 0, J1, 1024, J2, (bf16_t*)(ws + WS_WUP2), 1024, 0, scr, lane)) continue;
            if (tr_job(r, A.w_up, F2, 0, FFH + J1, 1024, J2, (bf16_t*)(ws + WS_WUP2), 1024, J2, scr, lane)) continue;
            if (tr_job(r, A.w_down, 1024, 0, 0, FFH, 1024, (bf16_t*)(ws + WS_WDN1), FFH, 0, scr, lane)) continue;
            { const size_t base = (size_t)r * 512 + lane * 8; const f32x4 v0 = *(const f32x4*)(A.sgu_w + base), v1 = *(const f32x4*)(A.sgu_w + base + 4);
              *(u32x4*)((bf16_t*)(ws + WS_SGUW) + base) = pack8(v0, v1); }
        }
    }
    TSPRE(0); SEAM(0); DUMPG(0); TSTAMP(0);
    if (PHON(1) && IN(1)) {
        mod_rows(a.in[0], a.in[2], MALL, a.in[6], mod, 0, 1024, hbuf, gw, NGW, lane);
    }
    TSPRE(1); SEAM(1); DUMPG(1); TSTAMP(1);
    if (PHON(2) && IN(2)) for (int _r = 0; _r < NREP(2); ++_r) {
        Gemm g{hbuf, (const bf16_t*)(ws + WS_WIN), MALL, 3584, 1024}; OrderX S; S.init(MTOK, 3584, G, bid);
        EpiIn E{(bf16_t*)(ws + WS_UG), (bf16_t*)(ws + WS_ZB), (bf16_t*)(ws + WS_GATES), a.in[24]};
        gemm_phase<EpiIn, OrderX, true, true>(lds, g, S, E);
    }
    TSPRE(2); SEAM(2); DUMPG(2); TSTAMP(2);
    if (PHON(3) && IN(3)) for (int _r = 0; _r < NREP(3); ++_r) {
#ifndef NOS5AB
        for (int it = bid; it < 256; it += G) s5ab_item((((it & 7) * 8 + ((it >> 3) & 7)) >> 5) * 128 + (it >> 6) * 32 + (((it & 7) * 8 + ((it >> 3) & 7)) & 31), lds, (const bf16_t*)(ws + WS_PFRAG), (const bf16_t*)(ws + WS_UG), hbuf, (const bf16_t*)(ws + WS_WIN), (bf16_t*)(ws + WS_HPREV), a.in[8], a.in[9], a.in[10], tid, lane, wave);
#endif
#if defined(DBG_TS)
        if (DBG_TS == 103) ts_b = __builtin_amdgcn_s_memrealtime();
#endif
#ifndef NOSGU
        for (int it = bid; it < 256; it += G) sgu_item(it, lds, (const bf16_t*)(ws + WS_ZB), (const bf16_t*)(ws + WS_SGUW), a.in[21], a.in[18], a.in[19], (bf16_t*)(ws + WS_YAB) + 512, tid, lane, wave);
#endif
    }
    TSPRE(3); SEAM(3); DUMPG(3); TSTAMP(3);
    if (PHON(4) && IN(4)) for (int _r = 0; _r < NREP(4); ++_r) {
        for (int it = bid; it < 512; it += G) s5c_item(((it >> 5) >> 2) * 128 + ((it & 7) * 4 + ((it >> 3) & 3)) * 4 + ((it >> 5) & 3), lds, (const bf16_t*)(ws + WS_QFRAG), (const bf16_t*)(ws + WS_TFRAG), (const bf16_t*)(ws + WS_UG), (const bf16_t*)(ws + WS_HPREV), (bf16_t*)(ws + WS_GY), tid, lane, wave);
    }
    TSPRE(4); SEAM(4); DUMPG(4); TSTAMP(4);
    if (PHON(5) && IN(5)) for (int _r = 0; _r < NREP(5); ++_r) {
        Gemm g{(const bf16_t*)(ws + WS_GY), (const bf16_t*)(ws + WS_WGLU), MTOK, 512, 512}; OrderX S; S.init(MTOK, 512, G, bid);
        EpiGlu E{(const bf16_t*)(ws + WS_GY), (bf16_t*)(ws + WS_YAB), a.in[17]};
        gemm_phase<EpiGlu, OrderX, true, true>(lds, g, S, E);
    }
    TSPRE(5); SEAM(5); DUMPG(5); TSTAMP(5);
    if (PHON(6) && IN(6)) for (int _r = 0; _r < NREP(6); ++_r) {
        Gemm g{(const bf16_t*)(ws + WS_YAB), (const bf16_t*)(ws + WS_WPA), MTOK, 1024, 1024}; OrderX S; S.init(MTOK, 1024, G, bid);
        EpiMerge E{(const bf16_t*)(ws + WS_GATES), (bf16_t*)(ws + WS_MBUF)};
        gemm_phase<EpiMerge, OrderX, true, true>(lds, g, S, E);
    }
    TSPRE(6); SEAM(6); DUMPG(6); TSTAMP(6);
    if (PHON(7) && IN(7)) for (int _r = 0; _r < NREP(7); ++_r) {
        Gemm g{(const bf16_t*)(ws + WS_MBUF), (const bf16_t*)(ws + WS_WOUT), MTOK, 1024, 1024}; OrderX S; S.init(MTOK, 1024, G, bid);
        EpiRes E{a.in[0], a.out, mod + 2048};
        gemm_phase<EpiRes, OrderX, true, true>(lds, g, S, E);
    }
    TSPRE(7); SEAM(7); DUMPG(7); TSTAMP(7);
    if (PHON(8) && IN(8)) for (int _r = 0; _r < NREP(8); ++_r) mod_rows2(a.out, nullptr, MTOK, a.in[26], mod, 3072, 4096, hbuf, gw, NGW, lane);
    TSPRE(8); SEAM(8); DUMPG(8); TSTAMP(8);
    if (PHON(9) && IN(9)) for (int _r = 0; _r < NREP(9); ++_r) {
        Gemm g{hbuf, (const bf16_t*)(ws + WS_WUP1), MTOK, 2 * J1, 1024}; OrderX S; S.init(MTOK, 2 * J1, G, bid);
        EpiPlain E{(bf16_t*)(ws + WS_UPB), 2 * J1};
        gemm_phase<EpiPlain, OrderX, true, true>(lds, g, S, E);
    }
#ifdef DBG_DUP9
    if (PHON(9) && IN(9)) {
        Gemm g{hbuf, (const bf16_t*)(ws + WS_WUP1), MTOK, 2 * J1, 1024}; OrderX S; S.init(MTOK, 2 * J1, G, bid);
        EpiPlain E{(bf16_t*)(ws + WS_UPB), 2 * J1};
        gemm_phase<EpiPlain, OrderX, true, true>(lds, g, S, E);
    }
#endif
    TSPRE(9); SEAM(9); DUMPG(9); TSTAMP(9);
    if (PHON(10) && IN(10)) for (int _r = 0; _r < NREP(10); ++_r) conv_phase((const bf16_t*)(ws + WS_UPB), J1, 0, a.in[28], a.in[29], (bf16_t*)(ws + WS_ACT1), lds, bid, G, tid);
    TSPRE(10); SEAM(10); DUMPG(10); TSTAMP(10);
    if (PHON(11) && IN(11)) for (int _r = 0; _r < NREP(11); ++_r) {
        Gemm g{hbuf, (const bf16_t*)(ws + WS_WUP2), MTOK, 2 * J2, 1024}; OrderX S; S.init(MTOK, 2 * J2, G, bid);
        EpiPlain E{(bf16_t*)(ws + WS_UPB), 2 * J2};
        gemm_phase<EpiPlain, OrderX, true, true>(lds, g, S, E);
    }
    TSPRE(11); SEAM(11); DUMPG(11); TSTAMP(11);
    if (PHON(12) && IN(12)) for (int _r = 0; _r < NREP(12); ++_r) conv_phase((const bf16_t*)(ws + WS_UPB), J2, J1, a.in[28], a.in[29], (bf16_t*)(ws + WS_ACT1), lds, bid, G, tid);
    TSPRE(12); SEAM(12); DUMPG(12); TSTAMP(12);
    if (PHON(13) && IN(13)) for (int _r = 0; _r < NREP(13); ++_r) {
        Gemm g{(const bf16_t*)(ws + WS_ACT1), (const bf16_t*)(ws + WS_WDN1), MTOK, 1024, FFH}; OrderX S; S.init(MTOK, 1024, G, bid);
        EpiRes E{a.out, a.out, mod + 5120};
        gemm_phase<EpiRes, OrderX, true, true>(lds, g, S, E);
    }
    TSPRE(13); SEAM(13); DUMPG(13); TSTAMP(13);
    if (PHON(14) && IN(14)) for (int _r = 0; _r < NREP(14); ++_r) {
        const float* gf = a.in[31];
        for (int m0 = gw; m0 < MTOK; m0 += 2 * NGW) { const int m1 = m0 + NGW;
            f32x4* xr0 = (f32x4*)(a.out + (size_t)m0 * DM); f32x4* xr1 = (f32x4*)(a.out + (size_t)(m1 < MTOK ? m1 : m0) * DM);
            f32x4 v[4], w[4]; float s0 = 0.f, s1 = 0.f;
#pragma unroll
            for (int j = 0; j < 4; ++j) { v[j] = xr0[lane + 64 * j]; w[j] = xr1[lane + 64 * j]; }
#pragma unroll
            for (int j = 0; j < 4; ++j) { s0 += (v[j][0] * v[j][0] + v[j][1] * v[j][1]) + (v[j][2] * v[j][2] + v[j][3] * v[j][3]); s1 += (w[j][0] * w[j][0] + w[j][1] * w[j][1]) + (w[j][2] * w[j][2] + w[j][3] * w[j][3]); }
            const float rstd0 = rsqrtf(wave_sum(s0) * (1.f / DM) + EPS), rstd1 = rsqrtf(wave_sum(s1) * (1.f / DM) + EPS);
#pragma unroll
            for (int j = 0; j < 4; ++j) { const f32x4 g4 = ((const f32x4*)gf)[lane + 64 * j]; xr0[lane + 64 * j] = (v[j] * rstd0) * g4; if (m1 < MTOK) xr1[lane + 64 * j] = (w[j] * rstd1) * g4; } }
    }
#if defined(DBG_TS) || defined(DBG_TSEAM)
    TSTAMP(14);
    if (bid == 0 && tid == 0) { asm volatile("s_waitcnt vmcnt(0)" ::: "memory"); float tq = (float)(ts_b - ts_a) * 0.01f; a.out[0] += tq * 0.004f; }
#endif
#undef IN
#undef SEAM
}

#ifndef MK_SPLIT
#define MK_SPLIT 0
#endif
extern "C" void kernel_launch(void* const* d_in, const int* in_sizes, int n_in, void* d_out, int out_size, void* d_ws, size_t ws_size, hipStream_t stream) {
    static int grid = 0;
    if (grid == 0) {
        if (n_in != 32 || out_size != MTOK * DM || ws_size < WS_END) { fprintf(stderr, "kernel_launch: unexpected shapes (n_in %d out %d ws %zu)\n", n_in, out_size, ws_size); grid = -1; return; }
        int dev = 0, cus = 0, per_cu = 0;
        hipGetDevice(&dev); hipDeviceGetAttribute(&cus, hipDeviceAttributeMultiprocessorCount, dev);
        if (hipFuncSetAttribute((const void*)fwd_kernel, hipFuncAttributeMaxDynamicSharedMemorySize, LDS_BYTES) != hipSuccess) { fprintf(stderr, "kernel_launch: hipFuncSetAttribute failed\n"); grid = -1; return; }
        if (hipOccupancyMaxActiveBlocksPerMultiprocessor(&per_cu, (const void*)fwd_kernel, NTHR, LDS_BYTES) != hipSuccess || per_cu < 1) { fprintf(stderr, "kernel_launch: occupancy query gave %d\n", per_cu); per_cu = 1; }
        (void)hipGetLastError();
        grid = cus * per_cu;
    }
    if (grid < 0) return;
    if (hipMemsetAsync((char*)d_ws + WS_BAR, 0, 16384, stream) != hipSuccess) { fprintf(stderr, "kernel_launch: memset failed\n"); return; }
    Args a{};
    for (int i = 0; i < 32; ++i) a.in[i] = (const float*)d_in[i];
    a.out = (float*)d_out; a.ws = (unsigned char*)d_ws;
#if MK_SPLIT
    for (int p = 0; p < NPHASE; ++p) { a.ph_lo = p; a.ph_hi = p + 1; hipLaunchKernelGGL(fwd_kernel, dim3(grid), dim3(NTHR), LDS_BYTES, stream, a); }
#else
    a.ph_lo = 0; a.ph_hi = NPHASE;
    void* args[] = {&a};
    hipError_t e = hipLaunchCooperativeKernel((const void*)fwd_kernel, dim3(grid), dim3(NTHR), args, LDS_BYTES, stream);
    if (e != hipSuccess) fprintf(stderr, "kernel_launch: cooperative launch failed: %s (grid %d)\n", hipGetErrorString(e), grid);
#endif
}
```

```cpp
#include <hip/hip_runtime.h>
#include <hip/hip_cooperative_groups.h>
#include <cstdio>
#include <cstdint>
namespace cg = cooperative_groups;
namespace pg8 {
#define PG8_LAS __attribute__((address_space(3)))
typedef unsigned short bf16_t;
typedef short bf16x8 __attribute__((ext_vector_type(8)));
typedef float f32x4 __attribute__((ext_vector_type(4)));
typedef unsigned u32x4 __attribute__((ext_vector_type(4)));
constexpr int BM = 256, BK = 64, HALF = 128, HTB = HALF * BK * 2  , STAGE_BYTES = 8 * HTB, NXCD = 8, WGM = 8;

__host__ __device__ __forceinline__ int lds_byte(int r, int c) { const int st = (r >> 4) * 2 + (c >> 5), rr = r & 15, cc = c & 31, ob = rr * 64 + cc * 2; return st * 1024 + (ob ^ (((ob >> 9) & 1) << 5)); }
__host__ __device__ __forceinline__ void stage_rc(int b, int& R, int& C) { const int st = b / 1024, sb = b % 1024, swz = sb ^ (((sb >> 9) & 1) << 5); R = (st >> 1) * 16 + swz / 64; C = (st & 1) * 32 + (swz % 64) / 2; }
__host__ __device__ __forceinline__ int perm32(int rho) { const int n = rho >> 4, i = rho & 15; return 8 * (i >> 2) + 4 * n + (i & 3); }

struct Unit { int pm, pn; };
struct Gemm { const bf16_t* A; const bf16_t* Bt; int M, N, K; };

struct StaticOrder {
    int nM, nN, nwg, G, c;
    __host__ __device__ void init(int M, int N, int G_, int c_) { nM = M / BM; nN = N / BM; nwg = nM * nN; G = G_; c = c_; }
    __host__ __device__ bool next(int i, Unit& u) const {
        const long L = (long)i * G + c; if (L >= nwg) return false;
        int wgid = (int)L; { const int q = nwg / NXCD, r = nwg % NXCD, xcd = wgid % NXCD, off = wgid / NXCD; wgid = (xcd < r ? xcd * (q + 1) : r * (q + 1) + (xcd - r) * q) + off; }
        const int nig = WGM * nN, gid = wgid / nig, fm = gid * WGM, gsz = (nM - fm) < WGM ? (nM - fm) : WGM;
        u.pm = fm + ((wgid % nig) % gsz); u.pn = (wgid % nig) / gsz; return true;
    }
    __device__ __forceinline__ void a_ready(const Unit&) const {}
    __device__ __forceinline__ void done(const Unit&) const {}
};

__device__ __forceinline__ unsigned cvt_pk_bf16(float lo, float hi) { unsigned r; asm volatile("v_cvt_pk_bf16_f32 %0, %1, %2" : "=v"(r) : "v"(lo), "v"(hi)); return r; }
template <class Epi, class Sched, bool ALIGN_EPI = false, bool SP2 = false>
__device__ __forceinline__ void gemm_phase(PG8_LAS unsigned char* lds, const Gemm g, const Sched& S, const Epi& E) {
    const int tid = threadIdx.x, wid = __builtin_amdgcn_readfirstlane(tid >> 6), lane = tid & 63, wr = wid >> 2, wc = wid & 3, fr = lane & 15, fq = lane >> 4;
    const int K = g.K, nt = K / BK;
    unsigned voffA[2], voffB[2];
#pragma unroll
    for (int i = 0; i < 2; ++i) { int R, C; stage_rc(tid * 16 + i * 8192, R, C); const int Rb = Epi::PERM ? ((R & ~31) + perm32(R & 31)) : R;
        voffA[i] = (unsigned)(R * K + C) * 2u; voffB[i] = (unsigned)(Rb * K + C) * 2u; }
    const size_t kstep = (size_t)(BK * 2);
    const size_t hstep = (size_t)HALF * K * 2;
    const size_t tstep = 2 * hstep;
    const unsigned ldsw = (unsigned)wid * 1024u;
    const int aoff = lds_byte(wr * 64 + fr, fq * 8), boff = lds_byte(wc * 32 + fr, fq * 8);
#define PG8_SA(b, h) (((b) * 2 + (h)) * HTB)
#define PG8_SB(b, h) ((4 + (b) * 2 + (h)) * HTB)
#define PG8_STAGE(bufoff, gbase, voff) do { _Pragma("unroll") for (int _i = 0; _i < 2; ++_i) \
        __builtin_amdgcn_global_load_lds((const unsigned*)((const char*)(gbase) + (voff)[_i]), (PG8_LAS unsigned*)(lds + (bufoff) + ldsw + _i * 8192), 16, 0, 0); } while (0)
#define PG8_LDA(dst, b, h) do { _Pragma("unroll") for (int m = 0; m < 4; ++m) _Pragma("unroll") for (int k = 0; k < 2; ++k) dst[m][k] = *(const PG8_LAS bf16x8*)(lds + PG8_SA(b, h) + aoff + m * 2048 + k * 1024); } while (0)
#define PG8_LDB(dst, b, h) do { _Pragma("unroll") for (int n = 0; n < 2; ++n) _Pragma("unroll") for (int k = 0; k < 2; ++k) dst[n][k] = *(const PG8_LAS bf16x8*)(lds + PG8_SB(b, h) + boff + n * 2048 + k * 1024); } while (0)
#define PG8_MMA(ai, bj, At, Bt) do { __builtin_amdgcn_s_setprio(1); _Pragma("unroll") for (int m = 0; m < 4; ++m) _Pragma("unroll") for (int n = 0; n < 2; ++n) _Pragma("unroll") for (int k = 0; k < 2; ++k) \
        acc[ai][bj][m][n] = __builtin_amdgcn_mfma_f32_16x16x32_bf16(Bt[n][k], At[m][k], acc[ai][bj][m][n], 0, 0, 0); __builtin_amdgcn_s_setprio(0); } while (0)
#define PG8_WAIT_V(n) asm volatile("s_waitcnt vmcnt(" #n ")" ::: "memory")
#define PG8_WAIT_L(n) asm volatile("s_waitcnt lgkmcnt(" #n ")" ::: "memory")
#define PG8_BAR __builtin_amdgcn_s_barrier()
#define PG8_SCHED __builtin_amdgcn_sched_barrier(0)
    Unit cur, nxt; int ui = 0;
    if (!S.next(0, cur)) return;
    f32x4 acc[2][2][4][2];
#pragma unroll
    for (int a = 0; a < 2; ++a)
#pragma unroll
        for (int b = 0; b < 2; ++b)
#pragma unroll
            for (int m = 0; m < 4; ++m)
#pragma unroll
                for (int n = 0; n < 2; ++n) acc[a][b][m][n] = (f32x4){0.f, 0.f, 0.f, 0.f};
    bf16x8 At[4][2], B0[2][2], B1[2][2];
    const char* cA = (const char*)g.A + (size_t)cur.pm * tstep; const char* cB = (const char*)g.Bt + (size_t)cur.pn * tstep;
    S.a_ready(cur);
    if constexpr (SP2) {
        PG8_STAGE(PG8_SB(0, 0), cB, voffB); PG8_STAGE(PG8_SB(0, 1), cB + hstep, voffB); PG8_STAGE(PG8_SA(0, 0), cA, voffA); PG8_STAGE(PG8_SA(0, 1), cA + hstep, voffA);
        if (wr == 1) PG8_BAR;
        PG8_WAIT_V(2); PG8_BAR;
        PG8_STAGE(PG8_SB(1, 0), cB + kstep, voffB); PG8_STAGE(PG8_SA(1, 0), cA + kstep, voffA); PG8_STAGE(PG8_SB(1, 1), cB + hstep + kstep, voffB);
        PG8_WAIT_V(6); PG8_BAR;
    } else {
        PG8_STAGE(PG8_SB(0, 0), cB, voffB); PG8_STAGE(PG8_SA(0, 0), cA, voffA); PG8_STAGE(PG8_SB(0, 1), cB + hstep, voffB); PG8_STAGE(PG8_SA(0, 1), cA + hstep, voffA);
        if (wr == 1) PG8_BAR;
        PG8_WAIT_V(4); PG8_BAR;
        PG8_STAGE(PG8_SB(1, 0), cB + kstep, voffB); PG8_STAGE(PG8_SA(1, 0), cA + kstep, voffA); PG8_STAGE(PG8_SB(1, 1), cB + hstep + kstep, voffB);
        PG8_WAIT_V(6); PG8_BAR;
    }
    for (;;) {
        const bool has_next = S.next(ui + 1, nxt);
        const char* nA = has_next ? (const char*)g.A + (size_t)nxt.pm * tstep : cA; const char* nB = has_next ? (const char*)g.Bt + (size_t)nxt.pn * tstep : cB;
        for (int t = 0; t < nt; t += 2) {
            const bool last = (t == nt - 2);
            if constexpr (Epi::MIDHOOK) { if (t == (nt >> 1)) E.mid(acc, cur, wr, wc, fr, fq); }
            const char* a1 = cA + (size_t)(t + 1) * kstep;
            const char* a2 = last ? nA : cA + (size_t)(t + 2) * kstep; const char* b2 = last ? nB : cB + (size_t)(t + 2) * kstep;
            const char* a3 = a2 + kstep; const char* b3 = b2 + kstep;
            if (last && has_next) S.a_ready(nxt);
            if constexpr (SP2) {
            PG8_LDB(B0, 0, 0); PG8_LDB(B1, 0, 1); PG8_SCHED; PG8_LDA(At, 0, 0); PG8_STAGE(PG8_SA(1, 1), a1 + hstep, voffA);
            PG8_WAIT_V(8); PG8_WAIT_L(0); PG8_BAR; PG8_MMA(0, 0, At, B0); PG8_MMA(0, 1, At, B1); PG8_BAR; PG8_SCHED;
            PG8_LDA(At, 0, 1); PG8_STAGE(PG8_SB(0, 0), b2, voffB); PG8_STAGE(PG8_SB(0, 1), b2 + hstep, voffB); PG8_STAGE(PG8_SA(0, 0), a2, voffA);
            PG8_WAIT_V(8); PG8_WAIT_L(0); PG8_BAR; PG8_MMA(1, 0, At, B0); PG8_MMA(1, 1, At, B1); PG8_BAR; PG8_SCHED;
            PG8_LDB(B0, 1, 0); PG8_LDB(B1, 1, 1); PG8_SCHED; PG8_LDA(At, 1, 0); PG8_STAGE(PG8_SA(0, 1), a2 + hstep, voffA);
            PG8_WAIT_V(8); PG8_WAIT_L(0); PG8_BAR; PG8_MMA(0, 0, At, B0); PG8_MMA(0, 1, At, B1); PG8_BAR; PG8_SCHED;
            PG8_LDA(At, 1, 1); PG8_STAGE(PG8_SB(1, 0), b3, voffB); PG8_STAGE(PG8_SB(1, 1), b3 + hstep, voffB); PG8_STAGE(PG8_SA(1, 0), a3, voffA);
            PG8_WAIT_V(8); PG8_WAIT_L(0); PG8_BAR; PG8_MMA(1, 0, At, B0); PG8_MMA(1, 1, At, B1); PG8_BAR; PG8_SCHED;
            } else {
            PG8_LDB(B0, 0, 0); PG8_SCHED; PG8_LDA(At, 0, 0); PG8_STAGE(PG8_SA(1, 1), a1 + hstep, voffA);
            PG8_WAIT_L(8); PG8_BAR; PG8_WAIT_L(0); PG8_MMA(0, 0, At, B0); PG8_BAR; PG8_SCHED;
            PG8_LDB(B1, 0, 1); PG8_STAGE(PG8_SB(0, 0), b2, voffB);
            PG8_BAR; PG8_WAIT_L(0); PG8_MMA(0, 1, At, B1); PG8_BAR;
            PG8_LDA(At, 0, 1); PG8_STAGE(PG8_SA(0, 0), a2, voffA);
            PG8_BAR; PG8_WAIT_L(0); PG8_MMA(1, 0, At, B0); PG8_BAR; PG8_SCHED;
            PG8_STAGE(PG8_SB(0, 1), b2 + hstep, voffB);
            PG8_WAIT_V(6); PG8_BAR; PG8_MMA(1, 1, At, B1); PG8_BAR;
            PG8_LDB(B0, 1, 0); PG8_SCHED; PG8_LDA(At, 1, 0); PG8_STAGE(PG8_SA(0, 1), a2 + hstep, voffA);
            PG8_WAIT_L(8); PG8_BAR; PG8_WAIT_L(0); PG8_MMA(0, 0, At, B0); PG8_BAR; PG8_SCHED;
            PG8_LDB(B1, 1, 1); PG8_STAGE(PG8_SB(1, 0), b3, voffB);
            PG8_BAR; PG8_WAIT_L(0); PG8_MMA(0, 1, At, B1); PG8_BAR;
            PG8_LDA(At, 1, 1); PG8_STAGE(PG8_SA(1, 0), a3, voffA);
            PG8_BAR; PG8_WAIT_L(0); PG8_MMA(1, 0, At, B0); PG8_BAR; PG8_SCHED;
            PG8_STAGE(PG8_SB(1, 1), b3 + hstep, voffB);
            PG8_WAIT_V(6); PG8_BAR; PG8_MMA(1, 1, At, B1); PG8_BAR;
            }
        }
        if constexpr (ALIGN_EPI) { if (wr == 0) PG8_BAR; }
        if constexpr (!Epi::AFTER_DRAIN) { E(acc, cur, wr, wc, fr, fq); S.done(cur); }
        if (!has_next) break;
#pragma unroll
        for (int a = 0; a < 2; ++a)
#pragma unroll
            for (int b = 0; b < 2; ++b)
#pragma unroll
                for (int m = 0; m < 4; ++m)
#pragma unroll
                    for (int n = 0; n < 2; ++n) acc[a][b][m][n] = (f32x4){0.f, 0.f, 0.f, 0.f};
        cur = nxt; cA = nA; cB = nB; ++ui;
        if constexpr (ALIGN_EPI) { if (wr == 1) PG8_BAR; }
    }
    PG8_WAIT_V(0);
    if constexpr (!ALIGN_EPI) { if (wr == 0) PG8_BAR; }
    PG8_BAR;
    if constexpr (Epi::AFTER_DRAIN) { E.fused(acc, cur, wr, wc, fr, fq, lds, wid, lane); S.done(cur); }
#undef PG8_SA
#undef PG8_SB
#undef PG8_STAGE
#undef PG8_LDA
#undef PG8_LDB
#undef PG8_MMA
#undef PG8_WAIT_V
#undef PG8_WAIT_L
#undef PG8_BAR
#undef PG8_SCHED
}
}

#define LAS __attribute__((address_space(3)))
using pg8::bf16_t; using pg8::bf16x8; using pg8::f32x4; using pg8::u32x4; using pg8::Unit;
typedef unsigned u32x2 __attribute__((ext_vector_type(2)));
typedef float f32x2_t __attribute__((ext_vector_type(2)));
typedef __bf16 bf16x2_t __attribute__((ext_vector_type(2)));
__device__ __forceinline__ unsigned cvt_pk_bf16(float lo, float hi) { f32x2_t v = {lo, hi}; bf16x2_t b = __builtin_convertvector(v, bf16x2_t); return __builtin_bit_cast(unsigned, b); }

constexpr int DM = 1024, NB = 4, SEQ = 8192, MTOK = NB * SEQ, CTXL = 256, MCTX = NB * CTXL, MALL = MTOK + MCTX;
constexpr int LTOT = CTXL + SEQ, NCH = LTOT / 16, NMOD = 6 * DM;
constexpr int FFH = 2816, F2 = 2 * FFH, J1 = 1536, J2 = 1280;
constexpr int NTHR = 512, LDS_BYTES = 147456;
constexpr float EPS = 1e-6f;

constexpr size_t MiB = 1u << 20;
constexpr size_t WS_WUP1 = 0, WS_WUP2 = 6 * MiB, WS_WDN1 = 11 * MiB, WS_WDN2 = 14 * MiB;
constexpr size_t WS_WIN = 17 * MiB, WS_WGLU = 24 * MiB, WS_WPA = 24 * MiB + 512 * 1024, WS_WPB = 25 * MiB + 512 * 1024, WS_WOUT = 26 * MiB + 512 * 1024;
constexpr size_t WS_PFRAG = 29 * MiB, WS_QFRAG = 33 * MiB, WS_TFRAG = 37 * MiB, WS_SGUW = 38 * MiB, WS_MOD = 38 * MiB + 512 * 1024, WS_BAR = 39 * MiB;
constexpr size_t WS_HBUF = 40 * MiB, WS_ZB = 106 * MiB, WS_UG = 170 * MiB, WS_GATES = 203 * MiB, WS_SBUF = 331 * MiB, WS_HPREV = 397 * MiB,
                 WS_GY = 462 * MiB, WS_YAB = 40 * MiB, WS_MBUF = 331 * MiB;
constexpr size_t WS_UPB = 106 * MiB, WS_ACT1 = 298 * MiB, WS_ACT2 = 394 * MiB, WS_END = 474 * MiB;

__device__ __forceinline__ float bflo(unsigned w) { return __builtin_bit_cast(float, w << 16); }
__device__ __forceinline__ float bfhi(unsigned w) { return __builtin_bit_cast(float, w & 0xffff0000u); }
__device__ __forceinline__ float bf2f(bf16_t h) { return __builtin_bit_cast(float, ((unsigned)h) << 16); }
__device__ __forceinline__ bf16_t f2bf(float f) { unsigned u = __builtin_bit_cast(unsigned, f); return (bf16_t)((u + 0x7fffu + ((u >> 16) & 1u)) >> 16); }
__device__ __forceinline__ float sigm(float v) { return __builtin_amdgcn_rcpf(1.f + __expf(-v)); }
__device__ __forceinline__ float gelu_t(float x) { const float t = 1.5957691216057308f * (x + 0.044715f * x * x * x); return x * sigm(t); }
__device__ __forceinline__ float wave_sum(float v) {
#pragma unroll
    for (int o = 1; o < 64; o <<= 1) v += __shfl_xor(v, o);
    return v;
}
__device__ __forceinline__ u32x4 pack8(f32x4 a, f32x4 b) { u32x4 w; w.x = cvt_pk_bf16(a[0], a[1]); w.y = cvt_pk_bf16(a[2], a[3]); w.z = cvt_pk_bf16(b[0], b[1]); w.w = cvt_pk_bf16(b[2], b[3]); return w; }
__device__ __forceinline__ void unpack8(u32x4 w, f32x4& a, f32x4& b) { a = (f32x4){bflo(w.x), bfhi(w.x), bflo(w.y), bfhi(w.y)}; b = (f32x4){bflo(w.z), bfhi(w.z), bflo(w.w), bfhi(w.w)}; }
#define LDS_WAIT() asm volatile("s_waitcnt lgkmcnt(0)" ::: "memory")
#define MFMA16(a, b, c) __builtin_amdgcn_mfma_f32_16x16x32_bf16((a), (b), (c), 0, 0, 0)

struct OrderX {
    int nM, nN, nwg, G, c, nExtra, xpm0, xnN;
    __device__ void init(int M, int N, int G_, int c_, int nExtra_ = 0, int xpm0_ = 0, int xnN_ = 1) { nM = M / 256; nN = N / 256; nwg = nM * nN; G = G_; c = c_; nExtra = nExtra_; xpm0 = xpm0_; xnN = xnN_; }
    __device__ bool next(int i, Unit& u) const {
        const long L = (long)i * G + c; if (L >= nwg + nExtra) return false;
        if (L >= nwg) { const int e = (int)L - nwg; u.pm = xpm0 + e / xnN; u.pn = e % xnN; return true; }
        int wgid = (int)L; { const int q = nwg / 8, r = nwg % 8, xcd = wgid % 8, off = wgid / 8; wgid = (xcd < r ? xcd * (q + 1) : r * (q + 1) + (xcd - r) * q) + off; }
        const int nig = 8 * nN, gid = wgid / nig, fm = gid * 8, gsz = (nM - fm) < 8 ? (nM - fm) : 8;
        u.pm = fm + ((wgid % nig) % gsz); u.pn = (wgid % nig) / gsz; return true;
    }
    __device__ __forceinline__ void a_ready(const Unit&) const {}
    __device__ __forceinline__ void done(const Unit&) const {}
};

#define EPI_HEAD const int row0 = u.pm * 256 + wr * 64 + fr; const int col0 = u.pn * 256 + wc * 32 + 8 * fq;
#define EPI_LOOP _Pragma("unroll") for (int ai = 0; ai < 2; ++ai) _Pragma("unroll") for (int m = 0; m < 4; ++m) _Pragma("unroll") for (int bj = 0; bj < 2; ++bj)

struct EpiIn {
    static constexpr bool PERM = true, AFTER_DRAIN = false, MIDHOOK = false;
    bf16_t* ug; bf16_t* zb; bf16_t* gates; const float* bgate;
    __device__ __forceinline__ void operator()(const f32x4 (&acc)[2][2][4][2], const Unit& u, int wr, int wc, int fr, int fq) const {
        EPI_HEAD
        if (u.pn < 2) {
            EPI_LOOP { const int row = row0 + ai * 128 + m * 16, c = col0 + bj * 128;
                int b, pos; if (row < MTOK) { b = row >> 13; pos = CTXL + (row & (SEQ - 1)); } else { const int rr = row - MTOK; b = rr >> 8; pos = rr & (CTXL - 1); }
                const int g = c >> 4, hh = c & 15;
                *(u32x4*)(ug + ((size_t)(b * 32 + g) * LTOT + pos) * 16 + hh) = pack8(acc[ai][bj][m][0], acc[ai][bj][m][1]); }
        } else if (u.pn < 6) {
            EPI_LOOP { const int row = row0 + ai * 128 + m * 16, c = col0 + bj * 128 - 512;
                f32x4 v0 = acc[ai][bj][m][0], v1 = acc[ai][bj][m][1];
#pragma unroll
                for (int e = 0; e < 4; ++e) { v0[e] = gelu_t(v0[e]); v1[e] = gelu_t(v1[e]); }
                *(u32x4*)(zb + (size_t)row * 1024 + c) = pack8(v0, v1); }
        } else {
            f32x4 bv[2][2];
#pragma unroll
            for (int bj = 0; bj < 2; ++bj) { bv[bj][0] = *(const f32x4*)(bgate + col0 + bj * 128 - 1536); bv[bj][1] = *(const f32x4*)(bgate + col0 + bj * 128 - 1536 + 4); }
            EPI_LOOP { const int row = row0 + ai * 128 + m * 16, c = col0 + bj * 128 - 1536;
                f32x4 v0 = acc[ai][bj][m][0] + bv[bj][0], v1 = acc[ai][bj][m][1] + bv[bj][1];
#ifndef DBG_NOSIG
#pragma unroll
                for (int e = 0; e < 4; ++e) { v0[e] = sigm(v0[e]); v1[e] = sigm(v1[e]); }
#endif
                *(u32x4*)(gates + (size_t)row * 2048 + c) = pack8(v0, v1); }
        }
    }
};
struct EpiGlu {
    static constexpr bool PERM = true, AFTER_DRAIN = false, MIDHOOK = false;
    const bf16_t* gy; bf16_t* ya; const float* bias;
    __device__ __forceinline__ void operator()(const f32x4 (&acc)[2][2][4][2], const Unit& u, int wr, int wc, int fr, int fq) const {
        EPI_HEAD
        f32x4 bv[2][2];
#pragma unroll
        for (int bj = 0; bj < 2; ++bj) { bv[bj][0] = *(const f32x4*)(bias + col0 + bj * 128); bv[bj][1] = *(const f32x4*)(bias + col0 + bj * 128 + 4); }
        EPI_LOOP { const int row = row0 + ai * 128 + m * 16, c = col0 + bj * 128;
            f32x4 g0, g1; unpack8(*(const u32x4*)(gy + (size_t)row * 512 + c), g0, g1);
            f32x4 v0 = acc[ai][bj][m][0] + bv[bj][0], v1 = acc[ai][bj][m][1] + bv[bj][1];
#pragma unroll
            for (int e = 0; e < 4; ++e) { v0[e] = g0[e] * sigm(v0[e]); v1[e] = g1[e] * sigm(v1[e]); }
            *(u32x4*)(ya + (size_t)row * 1024 + c) = pack8(v0, v1); }
    }
};
struct EpiMerge {
    static constexpr bool PERM = true, AFTER_DRAIN = false, MIDHOOK = true;
    const bf16_t* gates; bf16_t* mb;
    __device__ __forceinline__ void mid(f32x4 (&acc)[2][2][4][2], const Unit& u, int wr, int wc, int fr, int fq) const {
        EPI_HEAD
        const char* gb_ = (const char*)gates;
        unsigned base = ((unsigned)row0 * 2048u + (unsigned)col0) * 2u;
        asm volatile("" : "+v"(base));
        EPI_LOOP { const unsigned off = base + (unsigned)(ai * 128 + m * 16) * 4096u + (unsigned)bj * 256u;
            f32x4 a0, a1, b0, b1; unpack8(*(const u32x4*)(gb_ + off), a0, a1); unpack8(*(const u32x4*)(gb_ + off + 2048), b0, b1);
#pragma unroll
            for (int e = 0; e < 4; ++e) { acc[ai][bj][m][0][e] *= a0[e] * __builtin_amdgcn_rcpf(b0[e]); acc[ai][bj][m][1][e] *= a1[e] * __builtin_amdgcn_rcpf(b1[e]); }
            if (bj == 1 && (m & 1)) __builtin_amdgcn_sched_barrier(0); }
    }
    __device__ __forceinline__ void operator()(const f32x4 (&acc)[2][2][4][2], const Unit& u, int wr, int wc, int fr, int fq) const {
        EPI_HEAD
        EPI_LOOP { const int row = row0 + ai * 128 + m * 16, c = col0 + bj * 128;
            f32x4 b0, b1; unpack8(*(const u32x4*)(gates + (size_t)row * 2048 + 1024 + c), b0, b1);
            *(u32x4*)(mb + (size_t)row * 1024 + c) = pack8(b0 * acc[ai][bj][m][0], b1 * acc[ai][bj][m][1]); }
    }
};
struct EpiRes {
    static constexpr bool PERM = true, AFTER_DRAIN = false, MIDHOOK = false;
    const float* base; float* out; const float* gate;
    __device__ __forceinline__ void operator()(const f32x4 (&acc)[2][2][4][2], const Unit& u, int wr, int wc, int fr, int fq) const {
        EPI_HEAD
        const int b = (u.pm * 256) >> 13;
        f32x4 gv[2][2];
#pragma unroll
        for (int bj = 0; bj < 2; ++bj) { gv[bj][0] = *(const f32x4*)(gate + b * NMOD + col0 + bj * 128); gv[bj][1] = *(const f32x4*)(gate + b * NMOD + col0 + bj * 128 + 4); }
        EPI_LOOP { const int row = row0 + ai * 128 + m * 16, c = col0 + bj * 128;
            const f32x4 x0 = *(const f32x4*)(base + (size_t)row * 1024 + c), x1 = *(const f32x4*)(base + (size_t)row * 1024 + c + 4);
            *(f32x4*)(out + (size_t)row * 1024 + c) = x0 + gv[bj][0] * acc[ai][bj][m][0]; *(f32x4*)(out + (size_t)row * 1024 + c + 4) = x1 + gv[bj][1] * acc[ai][bj][m][1]; }
    }
};
struct EpiPlain {
    static constexpr bool PERM = true, AFTER_DRAIN = false, MIDHOOK = false;
    bf16_t* O; int ldc;
    __device__ __forceinline__ void operator()(const f32x4 (&acc)[2][2][4][2], const Unit& u, int wr, int wc, int fr, int fq) const {
        EPI_HEAD
        EPI_LOOP { const int row = row0 + ai * 128 + m * 16, c = col0 + bj * 128;
            *(u32x4*)(O + (size_t)row * ldc + c) = pack8(acc[ai][bj][m][0], acc[ai][bj][m][1]); }
    }
};

__device__ __forceinline__ void tr_item(const float* W, int ldw, int k0s, int n0s, bf16_t* WT, int dpitch, int k0d, int n0d, LAS float* scr, int lane) {
    f32x4 t[8];
#pragma unroll
    for (int i = 0; i < 8; ++i) { const int kk = (lane >> 3) + 8 * i; t[i] = *(const f32x4*)(W + (size_t)(k0s + kk) * ldw + n0s + (lane & 7) * 4); }
#pragma unroll
    for (int i = 0; i < 8; ++i) { const int kk = (lane >> 3) + 8 * i; LAS float* q = scr + kk * 33 + (lane & 7) * 4; q[0] = t[i][0]; q[1] = t[i][1]; q[2] = t[i][2]; q[3] = t[i][3]; }
    LDS_WAIT();
    const int c = lane & 7;
#pragma unroll
    for (int j = 0; j < 4; ++j) { const int n = (lane >> 3) + 8 * j; const LAS float* s = scr + (8 * c) * 33 + n;
        u32x4 o; o.x = cvt_pk_bf16(s[0 * 33], s[1 * 33]); o.y = cvt_pk_bf16(s[2 * 33], s[3 * 33]); o.z = cvt_pk_bf16(s[4 * 33], s[5 * 33]); o.w = cvt_pk_bf16(s[6 * 33], s[7 * 33]);
        *(u32x4*)(WT + (size_t)(n0d + n) * dpitch + k0d + 8 * c) = o; }
    LDS_WAIT();
}
__device__ __forceinline__ bool tr_job(int& r, const float* W, int ldw, int ks, int ns, int nK, int nN, bf16_t* WT, int dp, int nd0, LAS float* scr, int lane, int kd0 = 0) {
    const int nb = nN / 32, items = (nK / 64) * nb;
    if (r < items) { const int kb = r / nb, nbi = r % nb; tr_item(W, ldw, ks + 64 * kb, ns + 32 * nbi, WT, dp, kd0 + 64 * kb, nd0 + 32 * nbi, scr, lane); return true; }
    r -= items; return false;
}

struct P0Args { const float *c, *cctx, *wada, *bada, *w_in, *w_glu, *w_pa, *w_pb, *w_out, *w_up, *w_down, *sgu_w;
                const float *a_re, *a_im, *logstep, *b_re, *b_im, *c_re, *c_im, *dskip; };

__device__ __forceinline__ void p0_gemv_item(int it, const P0Args& A, float* mod, LAS unsigned char* lds, int tid, int lane, int wave) {
    LAS float* sv = (LAS float*)(lds); LAS float* red = (LAS float*)(lds + 24576);
    for (int i = tid; i < 5 * 1024; i += NTHR) { const int r = i >> 10, k = i & 1023; const float v = r < 4 ? A.c[r * 1024 + k] : A.cctx[k]; sv[i] = v / (1.f + expf(-v)); }
    __syncthreads();
    const int n = it * 64 + lane, k0 = wave * 128;
    float a0 = 0.f, a1 = 0.f, a2 = 0.f, a3 = 0.f, a4 = 0.f;
#pragma unroll 32
    for (int kk = 0; kk < 128; ++kk) { const float w = A.wada[(size_t)(k0 + kk) * NMOD + n];
        a0 += sv[k0 + kk] * w; a1 += sv[1024 + k0 + kk] * w; a2 += sv[2048 + k0 + kk] * w; a3 += sv[3072 + k0 + kk] * w; a4 += sv[4096 + k0 + kk] * w; }
    red[(wave * 5 + 0) * 64 + lane] = a0; red[(wave * 5 + 1) * 64 + lane] = a1; red[(wave * 5 + 2) * 64 + lane] = a2; red[(wave * 5 + 3) * 64 + lane] = a3; red[(wave * 5 + 4) * 64 + lane] = a4;
    __syncthreads();
    if (tid < 320) { const int r = tid >> 6, l = tid & 63; float s = 0.f;
#pragma unroll
        for (int w = 0; w < 8; ++w) s += red[(w * 5 + r) * 64 + l];
        mod[r * NMOD + it * 64 + l] = s + A.bada[it * 64 + l]; }
    __syncthreads();
}

__device__ __forceinline__ void p0_s5_item(int dg, const P0Args& A, bf16_t* pfrag, bf16_t* qfrag, bf16_t* tfrag, LAS unsigned char* lds, int tid) {
    const int d = dg >> 5, g = dg & 31;
    LAS float* apr = (LAS float*)lds;
    LAS float* api = apr + 17 * 64;
    LAS float* bbr = api + 17 * 64;
    LAS float* bbi = bbr + 1024;
    LAS float* cr = bbi + 1024;
    LAS float* ci = cr + 1024;
    LAS float* T = ci + 1024;
    const float dt = expf(A.logstep[dg]);
    const float* are = A.a_re + dg * 64; const float* aim = A.a_im + dg * 64;
    for (int i = tid; i < 17 * 64; i += NTHR) { const int k = i >> 6, n = i & 63; const float kd = (float)k * dt; const float mag = expf(kd * are[n]); const float ang = kd * aim[n];
        apr[i] = mag * cosf(ang); api[i] = mag * sinf(ang); }
    for (int i = tid; i < 1024; i += NTHR) { cr[i] = A.c_re[dg * 1024 + i]; ci[i] = A.c_im[dg * 1024 + i]; }
    __syncthreads();
    for (int i = tid; i < 1024; i += NTHR) { const int n = i >> 4; const float ar = are[n], ai = aim[n]; const float p = apr[64 + n] - 1.f, q = api[64 + n]; const float den = ar * ar + ai * ai;
        const float kr = (p * ar + q * ai) / den, ki = (q * ar - p * ai) / den; const float br = A.b_re[dg * 1024 + i], bi = A.b_im[dg * 1024 + i];
        bbr[i] = kr * br - ki * bi; bbi[i] = kr * bi + ki * br; }
    __syncthreads();
    if (tid < 256) { const int lag = tid >> 4, ho = tid & 15; f32x4 s[4];
#pragma unroll
        for (int q = 0; q < 4; ++q) s[q] = (f32x4){0.f, 0.f, 0.f, 0.f};
        for (int n = 0; n < 64; ++n) { const float c_r = cr[ho * 64 + n], c_i = ci[ho * 64 + n], p_r = apr[lag * 64 + n], p_i = api[lag * 64 + n];
            const float qr = c_r * p_r - c_i * p_i, qi = c_r * p_i + c_i * p_r;
#pragma unroll
            for (int q = 0; q < 4; ++q) { const f32x4 b_r = *(const LAS f32x4*)(bbr + n * 16 + q * 4), b_i = *(const LAS f32x4*)(bbi + n * 16 + q * 4); s[q] += b_r * qr - b_i * qi; } }
#pragma unroll
        for (int q = 0; q < 4; ++q) *(LAS f32x4*)(T + tid * 16 + q * 4) = s[q];
        if (d == 0 && lag == 0) T[tid * 16 + ho] += A.dskip[g * 16 + ho]; }
    for (int f = tid; f < 4096; f += NTHR) { const int nt = f >> 9, ks = (f >> 6) & 7, ln = f & 63; const int col = nt * 16 + (ln & 15), kg = ln >> 4; const int jtok = ks * 2 + (kg >> 1), h0 = (kg & 1) * 8;
        const int n = col & 63, im = col >> 6; const int pw = d == 0 ? 15 - jtok : jtok; const float p_r = apr[pw * 64 + n], p_i = api[pw * 64 + n];
        float v[8];
#pragma unroll
        for (int e = 0; e < 8; ++e) { const float b_r = bbr[n * 16 + h0 + e], b_i = bbi[n * 16 + h0 + e]; v[e] = im ? (p_r * b_i + p_i * b_r) : (p_r * b_r - p_i * b_i); }
        u32x4 o; o.x = cvt_pk_bf16(v[0], v[1]); o.y = cvt_pk_bf16(v[2], v[3]); o.z = cvt_pk_bf16(v[4], v[5]); o.w = cvt_pk_bf16(v[6], v[7]);
        *(u32x4*)(pfrag + ((size_t)dg * 4096 + f) * 8) = o; }
    for (int f = tid; f < 4096; f += NTHR) { const int jout = f >> 8, ks = (f >> 6) & 3, ln = f & 63; const int ho = ln & 15, kg = ln >> 4; const int pw = d == 0 ? jout + 1 : 16 - jout;
        float v[8];
#pragma unroll
        for (int e = 0; e < 8; ++e) { const int kk = ks * 32 + kg * 8 + e, n = kk & 63, im = kk >> 6; const float c_r = cr[ho * 64 + n], c_i = ci[ho * 64 + n], p_r = apr[pw * 64 + n], p_i = api[pw * 64 + n];
            v[e] = im ? -(c_r * p_i + c_i * p_r) : (c_r * p_r - c_i * p_i); }
        u32x4 o; o.x = cvt_pk_bf16(v[0], v[1]); o.y = cvt_pk_bf16(v[2], v[3]); o.z = cvt_pk_bf16(v[4], v[5]); o.w = cvt_pk_bf16(v[6], v[7]);
        *(u32x4*)(qfrag + ((size_t)dg * 4096 + f) * 8) = o; }
    __syncthreads();
    for (int f = tid; f < 1024; f += NTHR) { const int dd = f >> 6, ln = f & 63; const int ho = ln & 15, kg = ln >> 4; const int lag = d == 0 ? dd - (kg >> 1) : dd - 1 + (kg >> 1); const int hi0 = (kg & 1) * 8;
        float v[8];
#pragma unroll
        for (int e = 0; e < 8; ++e) v[e] = lag >= 0 ? T[(lag & 15) * 256 + ho * 16 + hi0 + e] : 0.f;
        u32x4 o; o.x = cvt_pk_bf16(v[0], v[1]); o.y = cvt_pk_bf16(v[2], v[3]); o.z = cvt_pk_bf16(v[4], v[5]); o.w = cvt_pk_bf16(v[6], v[7]);
        *(u32x4*)(tfrag + ((size_t)dg * 1024 + f) * 8) = o; }
    __syncthreads();
}

__device__ __forceinline__ void mod_rows(const float* xs, const float* ctx, int nrows, const float* gamma, const float* mod, int shoff, int scoff, bf16_t* out, int gw, int NGW, int lane) {
    for (int mb = gw; mb < nrows; mb += 4 * NGW) {
        f32x4 v[4][4];
#pragma unroll
        for (int q = 0; q < 4; ++q) { const int m = (mb + q * NGW < nrows) ? mb + q * NGW : mb; const float* xr = (m < MTOK) ? xs + (size_t)m * DM : ctx + (size_t)(m - MTOK) * DM;
#pragma unroll
            for (int j = 0; j < 4; ++j) v[q][j] = __builtin_nontemporal_load((const f32x4*)xr + lane + 64 * j); }
#pragma unroll
        for (int q = 0; q < 4; ++q) { const int m = mb + q * NGW; float s = 0.f;
#pragma unroll
            for (int j = 0; j < 4; ++j) s += (v[q][j][0] * v[q][j][0] + v[q][j][1] * v[q][j][1]) + (v[q][j][2] * v[q][j][2] + v[q][j][3] * v[q][j][3]);
            const float rstd = rsqrtf(wave_sum(s) * (1.f / DM) + EPS);
            if (m < nrows) { const int mr = (m < MTOK) ? (m >> 13) : 4;
#pragma unroll
                for (int j = 0; j < 4; ++j) { const int col = 4 * (lane + 64 * j);
                    const f32x4 g4 = *(const f32x4*)(gamma + col), sc4 = *(const f32x4*)(mod + mr * NMOD + scoff + col), sh4 = *(const f32x4*)(mod + mr * NMOD + shoff + col);
                    const f32x4 o = (v[q][j] * rstd) * g4 * (sc4 + 1.f) + sh4; u32x2 w; w.x = cvt_pk_bf16(o[0], o[1]); w.y = cvt_pk_bf16(o[2], o[3]); *(u32x2*)(out + (size_t)m * DM + col) = w; } } }
    }
}
__device__ __forceinline__ void mod_rows2(const float* xs, const float* ctx, int nrows, const float* gamma, const float* mod, int shoff, int scoff, bf16_t* out, int gw, int NGW, int lane) {
    for (int mb = gw; mb < nrows; mb += 4 * NGW) {
        f32x4 v[4][4];
#pragma unroll
        for (int q = 0; q < 4; ++q) { const int m = (mb + q * NGW < nrows) ? mb + q * NGW : mb; const float* xr = (m < MTOK) ? xs + (size_t)m * DM : ctx + (size_t)(m - MTOK) * DM;
#pragma unroll
            for (int j = 0; j < 4; ++j) v[q][j] = ((const f32x4*)xr)[lane + 64 * j]; }
#pragma unroll
        for (int q = 0; q < 4; ++q) { const int m = mb + q * NGW; float s = 0.f;
#pragma unroll
            for (int j = 0; j < 4; ++j) s += (v[q][j][0] * v[q][j][0] + v[q][j][1] * v[q][j][1]) + (v[q][j][2] * v[q][j][2] + v[q][j][3] * v[q][j][3]);
            const float rstd = rsqrtf(wave_sum(s) * (1.f / DM) + EPS);
            if (m < nrows) { const int mr = (m < MTOK) ? (m >> 13) : 4;
#pragma unroll
                for (int j = 0; j < 4; ++j) { const int col = 4 * (lane + 64 * j);
                    const f32x4 g4 = *(const f32x4*)(gamma + col), sc4 = *(const f32x4*)(mod + mr * NMOD + scoff + col), sh4 = *(const f32x4*)(mod + mr * NMOD + shoff + col);
                    const f32x4 o = (v[q][j] * rstd) * g4 * (sc4 + 1.f) + sh4; u32x2 w; w.x = cvt_pk_bf16(o[0], o[1]); w.y = cvt_pk_bf16(o[2], o[3]); *(u32x2*)(out + (size_t)m * DM + col) = w; } } }
    }
}

constexpr int UCTX_OFF = 65536 + 16896;
#define CMULADD(hr, hi, ar, ai, sr, si) do { const float _nr = (ar) * (hr) - (ai) * (hi) + (sr), _ni = (ar) * (hi) + (ai) * (hr) + (si); (hr) = _nr; (hi) = _ni; } while (0)
__device__ __forceinline__ void s5_load_act(bf16x8 (&act)[8], int mt, LAS unsigned char* lds, const bf16_t* useq, int lane) {
    const int chunk = mt * 16 + (lane & 15), fq = lane >> 4;
    if (mt == 0) {
#pragma unroll
        for (int ks = 0; ks < 8; ++ks) act[ks] = *(const LAS bf16x8*)(lds + UCTX_OFF + (chunk * 256 + ks * 32 + fq * 8) * 2);
    } else if (mt > 0) {
#pragma unroll
        for (int ks = 0; ks < 8; ++ks) act[ks] = *(const bf16x8*)(useq + (size_t)chunk * 256 + ks * 32 + fq * 8);
    }
}
template <bool WRITE>
__device__ __forceinline__ void s5_tile(const bf16x8 (&act)[8], int mt, int d, LAS unsigned char* lds, bf16_t* hp, const float (&a16r)[4], const float (&a16i)[4], const float (&A4r)[4], const float (&A4i)[4],
                                        float (&Hr)[4], float (&Hi)[4], int lane) {
    const int n16 = lane & 15, fq = lane >> 4;
    const int qpos = d ? 3 - fq : fq;
#pragma unroll
    for (int t = 0; t < 4; ++t) {
        f32x4 are = {0.f, 0.f, 0.f, 0.f}, aim = {0.f, 0.f, 0.f, 0.f};
#pragma unroll
        for (int ks = 0; ks < 8; ++ks) { are = MFMA16(act[ks], *(const LAS bf16x8*)(lds + ((t * 8 + ks) * 64 + lane) * 16), are);
                                         aim = MFMA16(act[ks], *(const LAS bf16x8*)(lds + (((t + 4) * 8 + ks) * 64 + lane) * 16), aim); }
        float sr[4], si[4];
#pragma unroll
        for (int k = 0; k < 4; ++k) { sr[k] = d ? are[3 - k] : are[k]; si[k] = d ? aim[3 - k] : aim[k]; }
        float gr = 0.f, gi = 0.f;
#pragma unroll
        for (int k = 0; k < 4; ++k) CMULADD(gr, gi, a16r[t], a16i[t], sr[k], si[k]);
        float run_r = Hr[t], run_i = Hi[t], my_r = 0.f, my_i = 0.f;
#pragma unroll
        for (int pos = 0; pos < 4; ++pos) { const int p = d ? 3 - pos : pos; const float pr = __shfl(gr, n16 + 16 * p), pi = __shfl(gi, n16 + 16 * p);
            if (pos == qpos) { my_r = run_r; my_i = run_i; }
            CMULADD(run_r, run_i, A4r[t], A4i[t], pr, pi); }
        Hr[t] = run_r; Hi[t] = run_i;
        if (WRITE) {
            float h_r = my_r, h_i = my_i; const int n = t * 16 + n16;
#pragma unroll
            for (int k = 0; k < 4; ++k) { const int cc = mt * 16 + fq * 4 + (d ? 3 - k : k);
                hp[(size_t)cc * 128 + n] = f2bf(h_r); hp[(size_t)cc * 128 + 64 + n] = f2bf(h_i);
                CMULADD(h_r, h_i, a16r[t], a16i[t], sr[k], si[k]); }
        }
    }
}

__device__ __forceinline__ void s5ab_item(int item, LAS unsigned char* lds, const bf16_t* pfrag, const bf16_t* ug, const bf16_t* hbuf, const bf16_t* win, bf16_t* hprev,
                                          const float* a_re, const float* a_im, const float* logstep, int tid, int lane, int wave) {
    const int d = item >> 7, b = (item >> 5) & 3, g = item & 31, dg = d * 32 + g;
    { const u32x4* src = (const u32x4*)(pfrag + (size_t)dg * 32768);
      for (int i = tid; i < 4096; i += NTHR) ((LAS u32x4*)lds)[i] = src[i]; }
    const bf16_t* useq = ug + (size_t)(b * 32 + g) * LTOT * 16;
    bf16_t* hp = hprev + (size_t)item * NCH * 128;
    LAS float* TT = (LAS float*)(lds + 65536);
    float a16r[4], a16i[4], A4r[4], A4i[4], ATr[4], ATi[4];
    { const float dt = expf(logstep[dg]);
#pragma unroll
      for (int t = 0; t < 4; ++t) { const int n = t * 16 + (lane & 15); const float k16 = 16.f * dt; const float mag = expf(k16 * a_re[dg * 64 + n]); const float ang = k16 * a_im[dg * 64 + n];
          const float r1 = mag * cosf(ang), i1 = mag * sinf(ang); a16r[t] = r1; a16i[t] = i1;
          const float r2 = r1 * r1 - i1 * i1, i2 = 2.f * r1 * i1; const float r4 = r2 * r2 - i2 * i2, i4 = 2.f * r2 * i2; A4r[t] = r4; A4i[t] = i4;
          const float r8 = r4 * r4 - i4 * i4, i8 = 2.f * r4 * i4; ATr[t] = r8 * r8 - i8 * i8; ATi[t] = 2.f * r8 * i8; } }
    for (int mtc = wave; mtc < 16; mtc += 8) {
        const bf16_t* ap = hbuf + ((size_t)(MTOK + b * 256 + mtc * 16 + (lane & 15))) * 1024 + (lane >> 4) * 8;
        const bf16_t* bp = win + ((size_t)(g * 16 + (lane & 15))) * 1024 + (lane >> 4) * 8;
        f32x4 acc = {0.f, 0.f, 0.f, 0.f};
#pragma unroll 16
        for (int ks = 0; ks < 32; ++ks) acc = MFMA16(*(const bf16x8*)(ap + ks * 32), *(const bf16x8*)(bp + ks * 32), acc);
        LAS bf16_t* uc = (LAS bf16_t*)(lds + UCTX_OFF);
#pragma unroll
        for (int r = 0; r < 4; ++r) uc[(mtc * 16 + (lane >> 4) * 4 + r) * 16 + (lane & 15)] = f2bf(acc[r]);
    }
    __syncthreads();
#define S5_NTH(k) (d == 0 ? ((wave + 8 * (k)) < NCH / 16 ? wave + 8 * (k) : -1) : (wave == 0 ? ((k) == 0 ? 0 : ((k) <= 4 ? 40 - 8 * (k) : -1)) : ((k) <= 3 ? 24 + wave - 8 * (k) : -1)))
    { bf16x8 actA[8], actB[8]; int mt = S5_NTH(0); s5_load_act(actA, mt, lds, useq, lane);
      for (int k = 0; mt >= 0; ++k) { const int nx = S5_NTH(k + 1); s5_load_act(actB, nx, lds, useq, lane);
        float Hr[4] = {0.f, 0.f, 0.f, 0.f}, Hi[4] = {0.f, 0.f, 0.f, 0.f};
        s5_tile<false>(actA, mt, d, lds, hp, a16r, a16i, A4r, A4i, Hr, Hi, lane);
        if (lane < 16) {
#pragma unroll
            for (int t = 0; t < 4; ++t) { TT[(mt * 64 + t * 16 + lane) * 2] = Hr[t]; TT[(mt * 64 + t * 16 + lane) * 2 + 1] = Hi[t]; } }
#pragma unroll
        for (int ks = 0; ks < 8; ++ks) actA[ks] = actB[ks];
        mt = nx; } }
    __syncthreads();
    { float Hr[4] = {0.f, 0.f, 0.f, 0.f}, Hi[4] = {0.f, 0.f, 0.f, 0.f};
      bf16x8 actA[8]; int k = 0, mine = S5_NTH(0); s5_load_act(actA, mine, lds, useq, lane);
      for (int idx = 0; idx < NCH / 16; ++idx) { const int mt = d ? (idx == 0 ? 0 : NCH / 16 - idx) : idx;
          if (mt == mine) { float Tr[4], Ti[4];
#pragma unroll
              for (int t = 0; t < 4; ++t) { Tr[t] = Hr[t]; Ti[t] = Hi[t]; }
              bf16x8 actB[8]; ++k; const int nx = S5_NTH(k); s5_load_act(actB, nx, lds, useq, lane);
              s5_tile<true>(actA, mt, d, lds, hp, a16r, a16i, A4r, A4i, Tr, Ti, lane);
#pragma unroll
              for (int ks = 0; ks < 8; ++ks) actA[ks] = actB[ks];
              mine = nx; }
#pragma unroll
          for (int t = 0; t < 4; ++t) { const float sr = TT[(mt * 64 + t * 16 + (lane & 15)) * 2], si = TT[(mt * 64 + t * 16 + (lane & 15)) * 2 + 1]; CMULADD(Hr[t], Hi[t], ATr[t], ATi[t], sr, si); } } }
#undef S5_NTH
    __syncthreads();
}

constexpr int VTP = 136;
__device__ __forceinline__ void sgu_item(int chunk, LAS unsigned char* lds, const bf16_t* zb, const bf16_t* sguw16, const float* sgub, const float* lng, const float* lnb, bf16_t* yb, int tid, int lane, int wave) {
    LAS bf16_t* vT = (LAS bf16_t*)lds;
    float gl[8], bl[8];
#pragma unroll
    for (int e = 0; e < 8; ++e) { gl[e] = lng[lane + 64 * e]; bl[e] = lnb[lane + 64 * e]; }
    for (int ib = 0; ib < 16; ib += 4) {
        float v[4][8];
#pragma unroll
        for (int q = 0; q < 4; ++q) { const bf16_t* zr = zb + (size_t)(chunk * 128 + wave * 16 + ib + q) * 1024 + 512;
#pragma unroll
            for (int e = 0; e < 8; ++e) v[q][e] = bf2f(zr[lane + 64 * e]); }
#pragma unroll
        for (int q = 0; q < 4; ++q) { const int p = wave * 16 + ib + q; float s = 0.f;
#pragma unroll
            for (int e = 0; e < 8; ++e) s += v[q][e];
            const float mean = wave_sum(s) * (1.f / 512.f); float s2 = 0.f;
#pragma unroll
            for (int e = 0; e < 8; ++e) { v[q][e] -= mean; s2 += v[q][e] * v[q][e]; }
            const float rstd = rsqrtf(wave_sum(s2) * (1.f / 512.f) + EPS);
#pragma unroll
            for (int e = 0; e < 8; ++e) vT[(lane + 64 * e) * VTP + p] = f2bf(v[q][e] * rstd * gl[e] + bl[e]); }
    }
    __syncthreads();
    const int gg = wave, i_ = lane & 15, kg = lane >> 4;
    bf16x8 vf[4][4];
#pragma unroll
    for (int dt = 0; dt < 4; ++dt)
#pragma unroll
        for (int ks = 0; ks < 4; ++ks) vf[dt][ks] = *(const LAS bf16x8*)(vT + (gg * 64 + dt * 16 + i_) * VTP + ks * 32 + kg * 8);
    bf16x8 wf[4];
#pragma unroll
    for (int ks = 0; ks < 4; ++ks) wf[ks] = *(const bf16x8*)(sguw16 + ((size_t)(gg * 128 + i_)) * 128 + ks * 32 + kg * 8);
    for (int qt = 0; qt < 8; ++qt) { const int q = qt * 16 + i_; const size_t row = (size_t)chunk * 128 + q;
        bf16x8 wn[4]; u32x2 uz[4];
#pragma unroll
        for (int ks = 0; ks < 4; ++ks) wn[ks] = *(const bf16x8*)(sguw16 + ((size_t)(gg * 128 + ((qt + 1) & 7) * 16 + i_)) * 128 + ks * 32 + kg * 8);
#pragma unroll
        for (int dt = 0; dt < 4; ++dt) uz[dt] = *(const u32x2*)(zb + row * 1024 + gg * 64 + dt * 16 + kg * 4);
        const float bias = sgub[gg * 128 + q];
        f32x4 acc[4];
#pragma unroll
        for (int dt = 0; dt < 4; ++dt) { acc[dt] = (f32x4){0.f, 0.f, 0.f, 0.f};
#pragma unroll
            for (int ks = 0; ks < 4; ++ks) acc[dt] = MFMA16(vf[dt][ks], wf[ks], acc[dt]); }
#pragma unroll
        for (int dt = 0; dt < 4; ++dt) { const int c = gg * 64 + dt * 16 + kg * 4;
            u32x2 w; w.x = cvt_pk_bf16(bflo(uz[dt].x) * (acc[dt][0] + bias), bfhi(uz[dt].x) * (acc[dt][1] + bias)); w.y = cvt_pk_bf16(bflo(uz[dt].y) * (acc[dt][2] + bias), bfhi(uz[dt].y) * (acc[dt][3] + bias));
            *(u32x2*)(yb + row * 1024 + c) = w; }
#pragma unroll
        for (int ks = 0; ks < 4; ++ks) wf[ks] = wn[ks];
    }
    __syncthreads();
}

__device__ __forceinline__ void s5c_item(int item, LAS unsigned char* lds, const bf16_t* qfrag, const bf16_t* tfrag, const bf16_t* ug, const bf16_t* hprev, bf16_t* gy, int tid, int lane, int wave) {
    const int b = item >> 7, g = (item >> 2) & 31, quarter = item & 3;
    const bf16_t* useq = ug + (size_t)(b * 32 + g) * LTOT * 16;
    const int kg = lane >> 4;
    const int chunk = 16 + (quarter * 8 + wave) * 16 + (lane & 15);
    bf16x8 U[8];
#pragma unroll
    for (int ks = 0; ks < 8; ++ks) U[ks] = *(const bf16x8*)(useq + (size_t)chunk * 256 + ks * 32 + kg * 8);
    f32x4 acc[16];
#pragma unroll
    for (int j = 0; j < 16; ++j) acc[j] = (f32x4){0.f, 0.f, 0.f, 0.f};
#pragma unroll
    for (int d = 0; d < 2; ++d) {
        __syncthreads();
        { const u32x4* src = (const u32x4*)(qfrag + (size_t)(d * 32 + g) * 32768);
          for (int i = tid; i < 4096; i += NTHR) ((LAS u32x4*)lds)[i] = src[i];
          const u32x4* srt = (const u32x4*)(tfrag + (size_t)(d * 32 + g) * 8192);
          for (int i = tid; i < 1024; i += NTHR) ((LAS u32x4*)(lds + 65536))[i] = srt[i]; }
        const bf16_t* hp = hprev + ((size_t)((d * 4 + b) * 32 + g) * NCH + chunk) * 128;
        bf16x8 H[4];
#pragma unroll
        for (int ks = 0; ks < 4; ++ks) H[ks] = *(const bf16x8*)(hp + ks * 32 + kg * 8);
        __syncthreads();
#pragma unroll
        for (int jout = 0; jout < 16; ++jout) {
#pragma unroll
            for (int ks = 0; ks < 4; ++ks) acc[jout] = MFMA16(*(const LAS bf16x8*)(lds + ((jout * 4 + ks) * 64 + lane) * 16), H[ks], acc[jout]);
            if (d == 0) {
#pragma unroll
                for (int ks = 0; ks < 8; ++ks) if (2 * ks <= jout) acc[jout] = MFMA16(*(const LAS bf16x8*)(lds + 65536 + ((jout - 2 * ks) * 64 + lane) * 16), U[ks], acc[jout]);
            } else {
#pragma unroll
                for (int ks = 0; ks < 8; ++ks) if (2 * ks + 1 >= jout) acc[jout] = MFMA16(*(const LAS bf16x8*)(lds + 65536 + ((2 * ks - jout + 1) * 64 + lane) * 16), U[ks], acc[jout]);
            }
        }
    }
    const size_t rowb = (size_t)b * SEQ + (size_t)(chunk - 16) * 16; const int c = g * 16 + kg * 4;
#pragma unroll
    for (int jout = 0; jout < 16; ++jout) { u32x2 w; w.x = cvt_pk_bf16(gelu_t(acc[jout][0]), gelu_t(acc[jout][1])); w.y = cvt_pk_bf16(gelu_t(acc[jout][2]), gelu_t(acc[jout][3]));
        *(u32x2*)(gy + (rowb + jout) * 512 + c) = w; }
    __syncthreads();
}

struct CRow { f32x4 g[3], v[3]; };
__device__ __forceinline__ f32x4 unpack4(unsigned x, unsigned y) { return (f32x4){bflo(x), bfhi(x), bflo(y), bfhi(y)}; }
__device__ __forceinline__ u32x4 conv_load(const bf16_t* p, int rowstride, int J, int rr) {
    u32x4 R = {0u, 0u, 0u, 0u};
    if (p != nullptr && rr >= 0 && rr < 128) { const size_t off = (size_t)rr * rowstride; const u32x2 g = *(const u32x2*)(p + off), v = *(const u32x2*)(p + off + J); R = (u32x4){g.x, g.y, v.x, v.y}; }
    return R;
}
__device__ __forceinline__ void conv_acc(f32x4& ag, f32x4& av, const CRow& R, const f32x4 (&wg)[9], const f32x4 (&wv)[9], int kh) {
#pragma unroll
    for (int k = 0; k < 3; ++k) { ag += wg[kh * 3 + k] * R.g[k]; av += wv[kh * 3 + k] * R.v[k]; }
}
#define CONV_STEP(FP, FC, FN, PUN, PLD, HUN, HLD, SLOT, r) do { if ((r) < rend) { \
        const int rl_ = ((r) + 4 <= rend) ? (r) + 4 : 1000; PLD = conv_load(pC, rowstride, J, rl_); HLD = conv_load(pH, rowstride, J, rl_); \
        xl[(SLOT) * 640 + (w + 1) * 64 + cgp] = PUN; if (pHslot >= 0) xl[(SLOT) * 640 + pHslot * 64 + cgp] = HUN; \
        if ((r) >= r0) { f32x4 ag = bg, av = bv; conv_acc(ag, av, FP, wg, wv, 0); conv_acc(ag, av, FC, wg, wv, 1); conv_acc(ag, av, FN, wg, wv, 2); \
            u32x2 w_; w_.x = cvt_pk_bf16(ag[0] * sigm(ag[0]) * av[0], ag[1] * sigm(ag[1]) * av[1]); w_.y = cvt_pk_bf16(ag[2] * sigm(ag[2]) * av[2], ag[3] * sigm(ag[3]) * av[3]); \
            *(u32x2*)(ap + (size_t)(r) * 64 * FFH) = w_; } \
        asm volatile("s_waitcnt lgkmcnt(0)" ::: "memory"); __builtin_amdgcn_s_barrier(); asm volatile("" ::: "memory"); \
        { const u32x4 nl_ = xl[(SLOT) * 640 + w * 64 + cgp], nr_ = xl[(SLOT) * 640 + (w + 2) * 64 + cgp]; const u32x4 own_ = PUN; \
          FP.g[0] = unpack4(nl_.x, nl_.y); FP.v[0] = unpack4(nl_.z, nl_.w); FP.g[1] = unpack4(own_.x, own_.y); FP.v[1] = unpack4(own_.z, own_.w); FP.g[2] = unpack4(nr_.x, nr_.y); FP.v[2] = unpack4(nr_.z, nr_.w); } } } while (0)
__device__ __forceinline__ void conv_phase(const bf16_t* up, int J, int j0, const float* convw, const float* convb, bf16_t* act, LAS unsigned char* lds, int bid, int G, int tid) {
    const int ldu = 2 * J, nslab = J / 256, nitems = 4 * 8 * 8 * nslab, rowstride = 64 * ldu;
    LAS u32x4* xl = (LAS u32x4*)lds;
    const int cgp = tid & 63, w = tid >> 6;
    for (int it = bid; it < nitems; it += G) {
        const int slab = it % nslab; int t = it / nslab; const int cg8 = t & 7; t >>= 3; const int band = t & 7, b = t >> 3;
        const int col = cg8 * 8 + w, jg = slab * 256 + cgp * 4;
        f32x4 wg[9], wv[9];
#pragma unroll
        for (int k = 0; k < 9; ++k) { wg[k] = *(const f32x4*)(convw + k * F2 + j0 + jg); wv[k] = *(const f32x4*)(convw + k * F2 + FFH + j0 + jg); }
        const f32x4 bg = *(const f32x4*)(convb + j0 + jg), bv = *(const f32x4*)(convb + FFH + j0 + jg);
        const bf16_t* pC = up + ((size_t)b * SEQ + col) * ldu + jg;
        const int pHslot = (w == 0) ? 0 : ((w == 7) ? 9 : -1);
        const bf16_t* pH = (w == 0) ? (col > 0 ? pC - ldu : nullptr) : ((w == 7) ? (col < 63 ? pC + ldu : nullptr) : nullptr);
        bf16_t* ap = act + ((size_t)b * SEQ + col) * FFH + j0 + jg;
        const int r0 = band * 16, rend = r0 + 16;
        CRow F0, F1, F2; u32x4 P0, P1, P2, H0, H1, H2;
#pragma unroll
        for (int k = 0; k < 3; ++k) { F0.g[k] = F0.v[k] = F1.g[k] = F1.v[k] = F2.g[k] = F2.v[k] = (f32x4){0.f, 0.f, 0.f, 0.f}; }
        P0 = conv_load(pC, rowstride, J, r0 - 1); H0 = conv_load(pH, rowstride, J, r0 - 1); P1 = conv_load(pC, rowstride, J, r0); H1 = conv_load(pH, rowstride, J, r0); P2 = P1; H2 = H1;
        __syncthreads();
        for (int r = r0 - 3; r < rend; r += 3) {
            CONV_STEP(F0, F1, F2, P0, P2, H0, H2, 0, r);
            CONV_STEP(F1, F2, F0, P1, P0, H1, H0, 1, r + 1);
            CONV_STEP(F2, F0, F1, P2, P1, H2, H1, 2, r + 2);
        }
    }
    __syncthreads();
}

#define XB_TMO      128
#define XB_XCNT(j)  (256  + 64 * (j))
#define XB_XSUB(j)  (1280 + 64 * (j))
#define XB_XGEN(j)  (2304 + 64 * (j))
#define XB_TOP      3328
#define XB_TOPGEN   3392
#define XCD_BAR_WORDS 3456
#define XB_SPIN_CAP (1u << 18)
__device__ __forceinline__ unsigned xb_ld(unsigned* p)              { return __hip_atomic_load(p, __ATOMIC_RELAXED, __HIP_MEMORY_SCOPE_AGENT); }
__device__ __forceinline__ unsigned xb_add(unsigned* p, unsigned v) { return __hip_atomic_fetch_add(p, v, __ATOMIC_RELAXED, __HIP_MEMORY_SCOPE_AGENT); }
__device__ __forceinline__ unsigned xb_xcc_id() { return (unsigned)__builtin_amdgcn_s_getreg((3 << 11) | 20) & 0xFu; }
#define XB_SPIN(cond, bar) do { unsigned _sp = 0; while (cond) { __builtin_amdgcn_s_sleep(1); \
    if ((++_sp & 255u) == 0u) { if (xb_ld(&(bar)[XB_TMO])) break; if (_sp > XB_SPIN_CAP) { atomicAdd(&(bar)[XB_TMO], 1u); break; } } } } while (0)
struct XcdBarrier { unsigned* bar; unsigned x; volatile LAS unsigned* st; };
__device__ __forceinline__ XcdBarrier xcd_barrier_post(unsigned* bar, volatile LAS unsigned* st) {
    XcdBarrier b; b.bar = bar; b.x = xb_xcc_id(); b.st = st;
    if (threadIdx.x == 0) (void)xb_add(&bar[XB_XCNT(b.x)], 1u);
    return b;
}
__device__ __forceinline__ void xcd_barrier_complete(unsigned* bar, unsigned x, unsigned& nloc, unsigned& nx) {
    const unsigned G = gridDim.x * gridDim.y * gridDim.z;
    unsigned sum, cnt, mine, sp = 0u;
    for (;;) {
        sum = 0u; cnt = 0u; mine = 0u;
#pragma unroll
        for (unsigned j = 0; j < 16; ++j) { const unsigned c = xb_ld(&bar[XB_XCNT(j)]); sum += c; cnt += (c > 0u) ? 1u : 0u; mine = (j == x) ? c : mine; }
        if (sum == G) break;
        __builtin_amdgcn_s_sleep(1);
        if ((++sp & 255u) == 0u) { if (xb_ld(&bar[XB_TMO])) break; if (sp > XB_SPIN_CAP) { atomicAdd(&bar[XB_TMO], 1u); break; } }
    }
    nloc = mine > 0u ? mine : 1u; nx = cnt > 0u ? cnt : 1u;
}
__device__ __forceinline__ void xcd_barrier(const XcdBarrier& b) {
    asm volatile("s_waitcnt vmcnt(0)" ::: "memory");
    __syncthreads();
    if (threadIdx.x == 0) {
        unsigned* bar = b.bar;
        __builtin_amdgcn_s_waitcnt(0);
        unsigned nloc = b.st[0], nx = b.st[1];
        if (nloc == 0u) { xcd_barrier_complete(bar, b.x, nloc, nx); b.st[0] = nloc; b.st[1] = nx; }
        const unsigned old = xb_add(&bar[XB_XSUB(b.x)], 1u);
        const unsigned gen = old / nloc;
        if (old + 1u == (gen + 1u) * nloc) {
            __builtin_amdgcn_fence(__ATOMIC_RELEASE, "agent");
            asm volatile("s_waitcnt vmcnt(0)" ::: "memory");
            const unsigned og = xb_add(&bar[XB_TOP], 1u);
            const unsigned tg = og / nx;
            if (og + 1u == (tg + 1u) * nx) xb_add(&bar[XB_TOPGEN], 1u);
            else XB_SPIN(xb_ld(&bar[XB_TOPGEN]) == tg, bar);
            __builtin_amdgcn_fence(__ATOMIC_ACQUIRE, "agent");
            xb_add(&bar[XB_XGEN(b.x)], 1u);
            asm volatile("s_waitcnt vmcnt(0)" ::: "memory");
        } else {
            XB_SPIN(xb_ld(&bar[XB_XGEN(b.x)]) == gen, bar);
            __builtin_amdgcn_fence(__ATOMIC_ACQUIRE, "agent");
            asm volatile("s_waitcnt vmcnt(0)" ::: "memory");
        }
    }
    __syncthreads();
}

constexpr int NPHASE = 15;
struct Args { const float* in[32]; float* out; unsigned char* ws; int ph_lo, ph_hi; };

__global__ void __launch_bounds__(NTHR, 2) fwd_kernel(Args a) {
    extern __shared__ __attribute__((aligned(16))) unsigned char lds_raw[];
    LAS unsigned char* lds = (LAS unsigned char*)lds_raw;
    cg::grid_group grid = cg::this_grid();
    const int tid = threadIdx.x, lane = tid & 63, wave = __builtin_amdgcn_readfirstlane(tid >> 6);
    const int G = gridDim.x, bid = blockIdx.x, gw = bid * 8 + wave, NGW = G * 8;
    unsigned char* ws = a.ws;
    const int lo = a.ph_lo, hi = a.ph_hi;
#define IN(k) (lo <= (k) && (k) < hi)
#ifndef PHMASK
#define PHMASK 0x7fff
#endif
#define PHON(k) ((PHMASK >> (k)) & 1)
#ifndef REPMASK
#define REPMASK 0
#endif
#define NREP(k) (1 + ((REPMASK >> (k)) & 1))
#define SEAM(k) do { if (IN(k) && IN((k) + 1)) xcd_barrier(xbar); } while (0)
    if (tid < 16) ((LAS unsigned*)(lds + LDS_BYTES - 64))[tid] = 0u;
    __syncthreads();
    if (a.ph_lo < 0) grid.sync();
    const XcdBarrier xbar = xcd_barrier_post((unsigned*)(ws + WS_BAR), (volatile LAS unsigned*)(lds + LDS_BYTES - 64));
#define DUMPG(k) do { } while (0)
#if defined(DBG_TS)
    unsigned long long ts_a = 0, ts_b = 0;
    if (DBG_TS == 0) ts_a = __builtin_amdgcn_s_memrealtime();
#define TSTAMP(k) do { if ((k) + 1 == DBG_TS || ((k) == 2 && DBG_TS == 103)) ts_a = __builtin_amdgcn_s_memrealtime(); if ((k) == DBG_TS) ts_b = __builtin_amdgcn_s_memrealtime(); } while (0)
#elif defined(DBG_TSEAM)
    unsigned long long ts_a = 0, ts_b = 0;
#define TSTAMP(k) do { if ((k) == DBG_TSEAM) ts_b = __builtin_amdgcn_s_memrealtime(); } while (0)
#define TSPRE(k) do { if ((k) == DBG_TSEAM) ts_a = __builtin_amdgcn_s_memrealtime(); } while (0)
#else
#define TSTAMP(k) do { } while (0)
#endif
#ifndef TSPRE
#define TSPRE(k) do { } while (0)
#endif
    float* mod = (float*)(ws + WS_MOD);
    bf16_t* hbuf = (bf16_t*)(ws + WS_HBUF);
    using pg8::Gemm; using pg8::gemm_phase;

    P0Args A;
    { A.c = a.in[1]; A.cctx = a.in[3]; A.wada = a.in[4]; A.bada = a.in[5]; A.w_in = a.in[7]; A.w_glu = a.in[16]; A.w_pa = a.in[22]; A.w_pb = a.in[23]; A.w_out = a.in[25];
        A.w_up = a.in[27]; A.w_down = a.in[30]; A.sgu_w = a.in[20]; A.a_re = a.in[8]; A.a_im = a.in[9]; A.logstep = a.in[10]; A.b_re = a.in[11]; A.b_im = a.in[12]; A.c_re = a.in[13]; A.c_im = a.in[14]; A.dskip = a.in[15]; }
    if (PHON(0) && IN(0)) for (int _r = 0; _r < NREP(0); ++_r) {
        for (int it = bid; it < 96 + 64; it += G) {
            if (it < 96) p0_gemv_item(it, A, mod, lds, tid, lane, wave);
            else p0_s5_item(it - 96, A, (bf16_t*)(ws + WS_PFRAG), (bf16_t*)(ws + WS_QFRAG), (bf16_t*)(ws + WS_TFRAG), lds, tid);
        }
        __syncthreads();
        LAS float* scr = (LAS float*)(lds + wave * 16384);
        constexpr int NIT = 1792 + 128 + 256 + 256 + 512 + 2816 + 1408 + 256;
        const bool trall = G < 224;
        for (int it = trall ? gw : (bid - 160) * 8 + wave; it < NIT && (trall || bid >= 160); it += trall ? NGW : (G - 160) * 8) { int r = it;
            if (tr_job(r, A.w_in, 3584, 0, 0, 1024, 3584, (bf16_t*)(ws + WS_WIN), 1024, 0, scr, lane)) continue;
            if (tr_job(r, A.w_glu, 512, 0, 0, 512, 512, (bf16_t*)(ws + WS_WGLU), 512, 0, scr, lane)) continue;
            if (tr_job(r, A.w_pa, 1024, 0, 0, 512, 1024, (bf16_t*)(ws + WS_WPA), 1024, 0, scr, lane, 0)) continue;
            if (tr_job(r, A.w_pb, 1024, 0, 0, 512, 1024, (bf16_t*)(ws + WS_WPA), 1024, 0, scr, lane, 512)) continue;
            if (tr_job(r, A.w_out, 1024, 0, 0, 1024, 1024, (bf16_t*)(ws + WS_WOUT), 1024, 0, scr, lane)) continue;
            if (tr_job(r, A.w_up, F2, 0, 0, 1024, J1, (bf16_t*)(ws + WS_WUP1), 1024, 0, scr, lane)) continue;
            if (tr_job(r, A.w_up, F2, 0, FFH, 1024, J1, (bf16_t*)(ws + WS_WUP1), 1024, J1, scr, lane)) continue;
            if (tr_job(r, A.w_up, F2, 0, J1, 1024, J2, (bf16_t*)(ws + WS_WUP2), 1024, 0, scr, lane)) continue;
            if (tr_job(r, A.w_up, F2, 0, FFH + J1, 1024, J2, (bf16_t*)(ws + WS_WUP2), 1024, J2, scr, lane)) continue;
            if (tr_job(r, A.w_down, 1024, 0, 0, FFH, 1024, (bf16_t*)(ws + WS_WDN1), FFH, 0, scr, lane)) continue;
            { const size_t base = (size_t)r * 512 + lane * 8; const f32x4 v0 = *(const f32x4*)(A.sgu_w + base), v1 = *(const f32x4*)(A.sgu_w + base + 4);
              *(u32x4*)((bf16_t*)(ws + WS_SGUW) + base) = pack8(v0, v1); }
        }
    }
    TSPRE(0); SEAM(0); DUMPG(0); TSTAMP(0);
    if (PHON(1) && IN(1)) {
        mod_rows(a.in[0], a.in[2], MALL, a.in[6], mod, 0, 1024, hbuf, gw, NGW, lane);
    }
    TSPRE(1); SEAM(1); DUMPG(1); TSTAMP(1);
    if (PHON(2) && IN(2)) for (int _r = 0; _r < NREP(2); ++_r) {
        Gemm g{hbuf, (const bf16_t*)(ws + WS_WIN), MALL, 3584, 1024}; OrderX S; S.init(MTOK, 3584, G, bid);
        EpiIn E{(bf16_t*)(ws + WS_UG), (bf16_t*)(ws + WS_ZB), (bf16_t*)(ws + WS_GATES), a.in[24]};
        gemm_phase<EpiIn, OrderX, true, true>(lds, g, S, E);
    }
    TSPRE(2); SEAM(2); DUMPG(2); TSTAMP(2);
    if (PHON(3) && IN(3)) for (int _r = 0; _r < NREP(3); ++_r) {
#ifndef NOS5AB
        for (int it = bid; it < 256; it += G) s5ab_item((((it & 7) * 8 + ((it >> 3) & 7)) >> 5) * 128 + (it >> 6) * 32 + (((it & 7) * 8 + ((it >> 3) & 7)) & 31), lds, (const bf16_t*)(ws + WS_PFRAG), (const bf16_t*)(ws + WS_UG), hbuf, (const bf16_t*)(ws + WS_WIN), (bf16_t*)(ws + WS_HPREV), a.in[8], a.in[9], a.in[10], tid, lane, wave);
#endif
#if defined(DBG_TS)
        if (DBG_TS == 103) ts_b = __builtin_amdgcn_s_memrealtime();
#endif
#ifndef NOSGU
        for (int it = bid; it < 256; it += G) sgu_item(it, lds, (const bf16_t*)(ws + WS_ZB), (const bf16_t*)(ws + WS_SGUW), a.in[21], a.in[18], a.in[19], (bf16_t*)(ws + WS_YAB) + 512, tid, lane, wave);
#endif
    }
    TSPRE(3); SEAM(3); DUMPG(3); TSTAMP(3);
    if (PHON(4) && IN(4)) for (int _r = 0; _r < NREP(4); ++_r) {
        for (int it = bid; it < 512; it += G) s5c_item(((it >> 5) >> 2) * 128 + ((it & 7) * 4 + ((it >> 3) & 3)) * 4 + ((it >> 5) & 3), lds, (const bf16_t*)(ws + WS_QFRAG), (const bf16_t*)(ws + WS_TFRAG), (const bf16_t*)(ws + WS_UG), (const bf16_t*)(ws + WS_HPREV), (bf16_t*)(ws + WS_GY), tid, lane, wave);
    }
    TSPRE(4); SEAM(4); DUMPG(4); TSTAMP(4);
    if (PHON(5) && IN(5)) for (int _r = 0; _r < NREP(5); ++_r) {
        Gemm g{(const bf16_t*)(ws + WS_GY), (const bf16_t*)(ws + WS_WGLU), MTOK, 512, 512}; OrderX S; S.init(MTOK, 512, G, bid);
        EpiGlu E{(const bf16_t*)(ws + WS_GY), (bf16_t*)(ws + WS_YAB), a.in[17]};
        gemm_phase<EpiGlu, OrderX, true, true>(lds, g, S, E);
    }
    TSPRE(5); SEAM(5); DUMPG(5); TSTAMP(5);
    if (PHON(6) && IN(6)) for (int _r = 0; _r < NREP(6); ++_r) {
        Gemm g{(const bf16_t*)(ws + WS_YAB), (const bf16_t*)(ws + WS_WPA), MTOK, 1024, 1024}; OrderX S; S.init(MTOK, 1024, G, bid);
        EpiMerge E{(const bf16_t*)(ws + WS_GATES), (bf16_t*)(ws + WS_MBUF)};
        gemm_phase<EpiMerge, OrderX, true, true>(lds, g, S, E);
    }
    TSPRE(6); SEAM(6); DUMPG(6); TSTAMP(6);
    if (PHON(7) && IN(7)) for (int _r = 0; _r < NREP(7); ++_r) {
        Gemm g{(const bf16_t*)(ws + WS_MBUF), (const bf16_t*)(ws + WS_WOUT), MTOK, 1024, 1024}; OrderX S; S.init(MTOK, 1024, G, bid);
        EpiRes E{a.in[0], a.out, mod + 2048};
        gemm_phase<EpiRes, OrderX, true, true>(lds, g, S, E);
    }
    TSPRE(7); SEAM(7); DUMPG(7); TSTAMP(7);
    if (PHON(8) && IN(8)) for (int _r = 0; _r < NREP(8); ++_r) mod_rows2(a.out, nullptr, MTOK, a.in[26], mod, 3072, 4096, hbuf, gw, NGW, lane);
    TSPRE(8); SEAM(8); DUMPG(8); TSTAMP(8);
    if (PHON(9) && IN(9)) for (int _r = 0; _r < NREP(9); ++_r) {
        Gemm g{hbuf, (const bf16_t*)(ws + WS_WUP1), MTOK, 2 * J1, 1024}; OrderX S; S.init(MTOK, 2 * J1, G, bid);
        EpiPlain E{(bf16_t*)(ws + WS_UPB), 2 * J1};
        gemm_phase<EpiPlain, OrderX, true, true>(lds, g, S, E);
    }
#ifdef DBG_DUP9
    if (PHON(9) && IN(9)) {
        Gemm g{hbuf, (const bf16_t*)(ws + WS_WUP1), MTOK, 2 * J1, 1024}; OrderX S; S.init(MTOK, 2 * J1, G, bid);
        EpiPlain E{(bf16_t*)(ws + WS_UPB), 2 * J1};
        gemm_phase<EpiPlain, OrderX, true, true>(lds, g, S, E);
    }
#endif
    TSPRE(9); SEAM(9); DUMPG(9); TSTAMP(9);
    if (PHON(10) && IN(10)) for (int _r = 0; _r < NREP(10); ++_r) conv_phase((const bf16_t*)(ws + WS_UPB), J1, 0, a.in[28], a.in[29], (bf16_t*)(ws + WS_ACT1), lds, bid, G, tid);
    TSPRE(10); SEAM(10); DUMPG(10); TSTAMP(10);
    if (PHON(11) && IN(11)) for (int _r = 0; _r < NREP(11); ++_r) {
        Gemm g{hbuf, (const bf16_t*)(ws + WS_WUP2), MTOK, 2 * J2, 1024}; OrderX S; S.init(MTOK, 2 * J2, G, bid);
        EpiPlain E{(bf16_t*)(ws + WS_UPB), 2 * J2};
        gemm_phase<EpiPlain, OrderX, true, true>(lds, g, S, E);
    }
    TSPRE(11); SEAM(11); DUMPG(11); TSTAMP(11);
    if (PHON(12) && IN(12)) for (int _r = 0; _r < NREP(12); ++_r) conv_phase((const bf16_t*)(ws + WS_UPB), J2, J1, a.in[28], a.in[29], (bf16_t*)(ws + WS_ACT1), lds, bid, G, tid);
    TSPRE(12); SEAM(12); DUMPG(12); TSTAMP(12);
    if (PHON(13) && IN(13)) for (int _r = 0; _r < NREP(13); ++_r) {
        Gemm g{(const bf16_t*)(ws + WS_ACT1), (const bf16_t*)(ws + WS_WDN1), MTOK, 1024, FFH}; OrderX S; S.init(MTOK, 1024, G, bid);
        EpiRes E{a.out, a.out, mod + 5120};
        gemm_phase<EpiRes, OrderX, true, true>(lds, g, S, E);
    }
    TSPRE(13); SEAM(13); DUMPG(13); TSTAMP(13);
    if (PHON(14) && IN(14)) for (int _r = 0; _r < NREP(14); ++_r) {
        const float* gf = a.in[31];
        for (int m0 = gw; m0 < MTOK; m0 += 2 * NGW) { const int m1 = m0 + NGW;
            f32x4* xr0 = (f32x4*)(a.out + (size_t)m0 * DM); f32x4* xr1 = (f32x4*)(a.out + (size_t)(m1 < MTOK ? m1 : m0) * DM);
            f32x4 v[4], w[4]; float s0 = 0.f, s1 = 0.f;
#pragma unroll
            for (int j = 0; j < 4; ++j) { v[j] = xr0[lane + 64 * j]; w[j] = xr1[lane + 64 * j]; }
#pragma unroll
            for (int j = 0; j < 4; ++j) { s0 += (v[j][0] * v[j][0] + v[j][1] * v[j][1]) + (v[j][2] * v[j][2] + v[j][3] * v[j][3]); s1 += (w[j][0] * w[j][0] + w[j][1] * w[j][1]) + (w[j][2] * w[j][2] + w[j][3] * w[j][3]); }
            const float rstd0 = rsqrtf(wave_sum(s0) * (1.f / DM) + EPS), rstd1 = rsqrtf(wave_sum(s1) * (1.f / DM) + EPS);
#pragma unroll
            for (int j = 0; j < 4; ++j) { const f32x4 g4 = ((const f32x4*)gf)[lane + 64 * j]; xr0[lane + 64 * j] = (v[j] * rstd0) * g4; if (m1 < MTOK) xr1[lane + 64 * j] = (w[j] * rstd1) * g4; } }
    }
#if defined(DBG_TS) || defined(DBG_TSEAM)
    TSTAMP(14);
    if (bid == 0 && tid == 0) { asm volatile("s_waitcnt vmcnt(0)" ::: "memory"); float tq = (float)(ts_b - ts_a) * 0.01f; a.out[0] += tq * 0.004f; }
#endif
#undef IN
#undef SEAM
}

#ifndef MK_SPLIT
#define MK_SPLIT 0
#endif
extern "C" void kernel_launch(void* const* d_in, const int* in_sizes, int n_in, void* d_out, int out_size, void* d_ws, size_t ws_size, hipStream_t stream) {
    static int grid = 0;
    if (grid == 0) {
        if (n_in != 32 || out_size != MTOK * DM || ws_size < WS_END) { fprintf(stderr, "kernel_launch: unexpected shapes (n_in %d out %d ws %zu)\n", n_in, out_size, ws_size); grid = -1; return; }
        int dev = 0, cus = 0, per_cu = 0;
        hipGetDevice(&dev); hipDeviceGetAttribute(&cus, hipDeviceAttributeMultiprocessorCount, dev);
        if (hipFuncSetAttribute((const void*)fwd_kernel, hipFuncAttributeMaxDynamicSharedMemorySize, LDS_BYTES) != hipSuccess) { fprintf(stderr, "kernel_launch: hipFuncSetAttribute failed\n"); grid = -1; return; }
        if (hipOccupancyMaxActiveBlocksPerMultiprocessor(&per_cu, (const void*)fwd_kernel, NTHR, LDS_BYTES) != hipSuccess || per_cu < 1) { fprintf(stderr, "kernel_launch: occupancy query gave %d\n", per_cu); per_cu = 1; }
        (void)hipGetLastError();
        grid = cus * per_cu;
    }
    if (grid < 0) return;
    if (hipMemsetAsync((char*)d_ws + WS_BAR, 0, 16384, stream) != hipSuccess) { fprintf(stderr, "kernel_launch: memset failed\n"); return; }
    Args a{};
    for (int i = 0; i < 32; ++i) a.in[i] = (const float*)d_in[i];
    a.out = (float*)d_out; a.ws = (unsigned char*)d_ws;
#if MK_SPLIT
    for (int p = 0; p < NPHASE; ++p) { a.ph_lo = p; a.ph_hi = p + 1; hipLaunchKernelGGL(fwd_kernel, dim3(grid), dim3(NTHR), LDS_BYTES, stream, a); }
#else
    a.ph_lo = 0; a.ph_hi = NPHASE;
    void* args[] = {&a};
    hipError_t e = hipLaunchCooperativeKernel((const void*)fwd_kernel, dim3(grid), dim3(NTHR), args, LDS_BYTES, stream);
    if (e != hipSuccess) fprintf(stderr, "kernel_launch: cooperative launch failed: %s (grid %d)\n", hipGetErrorString(e), grid);
#endif
}
```

```cpp
#include <hip/hip_runtime.h>
#include <hip/hip_cooperative_groups.h>
#include <cstdio>
#include <cstdint>
namespace cg = cooperative_groups;
namespace pg8 {
#define PG8_LAS __attribute__((address_space(3)))
typedef unsigned short bf16_t;
typedef short bf16x8 __attribute__((ext_vector_type(8)));
typedef float f32x4 __attribute__((ext_vector_type(4)));
typedef unsigned u32x4 __attribute__((ext_vector_type(4)));
constexpr int BM = 256, BK = 64, HALF = 128, HTB = HALF * BK * 2  , STAGE_BYTES = 8 * HTB, NXCD = 8, WGM = 8;

__host__ __device__ __forceinline__ int lds_byte(int r, int c) { const int st = (r >> 4) * 2 + (c >> 5), rr = r & 15, cc = c & 31, ob = rr * 64 + cc * 2; return st * 1024 + (ob ^ (((ob >> 9) & 1) << 5)); }
__host__ __device__ __forceinline__ void stage_rc(int b, int& R, int& C) { const int st = b / 1024, sb = b % 1024, swz = sb ^ (((sb >> 9) & 1) << 5); R = (st >> 1) * 16 + swz / 64; C = (st & 1) * 32 + (swz % 64) / 2; }
__host__ __device__ __forceinline__ int perm32(int rho) { const int n = rho >> 4, i = rho & 15; return 8 * (i >> 2) + 4 * n + (i & 3); }

struct Unit { int pm, pn; };
struct Gemm { const bf16_t* A; const bf16_t* Bt; int M, N, K; };

struct StaticOrder {
    int nM, nN, nwg, G, c;
    __host__ __device__ void init(int M, int N, int G_, int c_) { nM = M / BM; nN = N / BM; nwg = nM * nN; G = G_; c = c_; }
    __host__ __device__ bool next(int i, Unit& u) const {
        const long L = (long)i * G + c; if (L >= nwg) return false;
        int wgid = (int)L; { const int q = nwg / NXCD, r = nwg % NXCD, xcd = wgid % NXCD, off = wgid / NXCD; wgid = (xcd < r ? xcd * (q + 1) : r * (q + 1) + (xcd - r) * q) + off; }
        const int nig = WGM * nN, gid = wgid / nig, fm = gid * WGM, gsz = (nM - fm) < WGM ? (nM - fm) : WGM;
        u.pm = fm + ((wgid % nig) % gsz); u.pn = (wgid % nig) / gsz; return true;
    }
    __device__ __forceinline__ void a_ready(const Unit&) const {}
    __device__ __forceinline__ void done(const Unit&) const {}
};

__device__ __forceinline__ unsigned cvt_pk_bf16(float lo, float hi) { unsigned r; asm volatile("v_cvt_pk_bf16_f32 %0, %1, %2" : "=v"(r) : "v"(lo), "v"(hi)); return r; }
template <class Epi, class Sched, bool ALIGN_EPI = false, bool SP2 = false>
__device__ __forceinline__ void gemm_phase(PG8_LAS unsigned char* lds, const Gemm g, const Sched& S, const Epi& E) {
    const int tid = threadIdx.x, wid = __builtin_amdgcn_readfirstlane(tid >> 6), lane = tid & 63, wr = wid >> 2, wc = wid & 3, fr = lane & 15, fq = lane >> 4;
    const int K = g.K, nt = K / BK;
    unsigned voffA[2], voffB[2];
#pragma unroll
    for (int i = 0; i < 2; ++i) { int R, C; stage_rc(tid * 16 + i * 8192, R, C); const int Rb = Epi::PERM ? ((R & ~31) + perm32(R & 31)) : R;
        voffA[i] = (unsigned)(R * K + C) * 2u; voffB[i] = (unsigned)(Rb * K + C) * 2u; }
    const size_t kstep = (size_t)(BK * 2);
    const size_t hstep = (size_t)HALF * K * 2;
    const size_t tstep = 2 * hstep;
    const unsigned ldsw = (unsigned)wid * 1024u;
    const int aoff = lds_byte(wr * 64 + fr, fq * 8), boff = lds_byte(wc * 32 + fr, fq * 8);
#define PG8_SA(b, h) (((b) * 2 + (h)) * HTB)
#define PG8_SB(b, h) ((4 + (b) * 2 + (h)) * HTB)
#define PG8_STAGE(bufoff, gbase, voff) do { _Pragma("unroll") for (int _i = 0; _i < 2; ++_i) \
        __builtin_amdgcn_global_load_lds((const unsigned*)((const char*)(gbase) + (voff)[_i]), (PG8_LAS unsigned*)(lds + (bufoff) + ldsw + _i * 8192), 16, 0, 0); } while (0)
#define PG8_LDA(dst, b, h) do { _Pragma("unroll") for (int m = 0; m < 4; ++m) _Pragma("unroll") for (int k = 0; k < 2; ++k) dst[m][k] = *(const PG8_LAS bf16x8*)(lds + PG8_SA(b, h) + aoff + m * 2048 + k * 1024); } while (0)
#define PG8_LDB(dst, b, h) do { _Pragma("unroll") for (int n = 0; n < 2; ++n) _Pragma("unroll") for (int k = 0; k < 2; ++k) dst[n][k] = *(const PG8_LAS bf16x8*)(lds + PG8_SB(b, h) + boff + n * 2048 + k * 1024); } while (0)
#define PG8_MMA(ai, bj, At, Bt) do { __builtin_amdgcn_s_setprio(1); _Pragma("unroll") for (int m = 0; m < 4; ++m) _Pragma("unroll") for (int n = 0; n < 2; ++n) _Pragma("unroll") for (int k = 0; k < 2; ++k) \
        acc[ai][bj][m][n] = __builtin_amdgcn_mfma_f32_16x16x32_bf16(Bt[n][k], At[m][k], acc[ai][bj][m][n], 0, 0, 0); __builtin_amdgcn_s_setprio(0); } while (0)
#define PG8_WAIT_V(n) asm volatile("s_waitcnt vmcnt(" #n ")" ::: "memory")
#define PG8_WAIT_L(n) asm volatile("s_waitcnt lgkmcnt(" #n ")" ::: "memory")
#define PG8_BAR __builtin_amdgcn_s_barrier()
#define PG8_SCHED __builtin_amdgcn_sched_barrier(0)
    Unit cur, nxt; int ui = 0;
    if (!S.next(0, cur)) return;
    f32x4 acc[2][2][4][2];
#pragma unroll
    for (int a = 0; a < 2; ++a)
#pragma unroll
        for (int b = 0; b < 2; ++b)
#pragma unroll
            for (int m = 0; m < 4; ++m)
#pragma unroll
                for (int n = 0; n < 2; ++n) acc[a][b][m][n] = (f32x4){0.f, 0.f, 0.f, 0.f};
    bf16x8 At[4][2], B0[2][2], B1[2][2];
    const char* cA = (const char*)g.A + (size_t)cur.pm * tstep; const char* cB = (const char*)g.Bt + (size_t)cur.pn * tstep;
    S.a_ready(cur);
    if constexpr (SP2) {
        PG8_STAGE(PG8_SB(0, 0), cB, voffB); PG8_STAGE(PG8_SB(0, 1), cB + hstep, voffB); PG8_STAGE(PG8_SA(0, 0), cA, voffA); PG8_STAGE(PG8_SA(0, 1), cA + hstep, voffA);
        if (wr == 1) PG8_BAR;
        PG8_WAIT_V(2); PG8_BAR;
        PG8_STAGE(PG8_SB(1, 0), cB + kstep, voffB); PG8_STAGE(PG8_SA(1, 0), cA + kstep, voffA); PG8_STAGE(PG8_SB(1, 1), cB + hstep + kstep, voffB);
        PG8_WAIT_V(6); PG8_BAR;
    } else {
        PG8_STAGE(PG8_SB(0, 0), cB, voffB); PG8_STAGE(PG8_SA(0, 0), cA, voffA); PG8_STAGE(PG8_SB(0, 1), cB + hstep, voffB); PG8_STAGE(PG8_SA(0, 1), cA + hstep, voffA);
        if (wr == 1) PG8_BAR;
        PG8_WAIT_V(4); PG8_BAR;
        PG8_STAGE(PG8_SB(1, 0), cB + kstep, voffB); PG8_STAGE(PG8_SA(1, 0), cA + kstep, voffA); PG8_STAGE(PG8_SB(1, 1), cB + hstep + kstep, voffB);
        PG8_WAIT_V(6); PG8_BAR;
    }
    for (;;) {
        const bool has_next = S.next(ui + 1, nxt);
        const char* nA = has_next ? (const char*)g.A + (size_t)nxt.pm * tstep : cA; const char* nB = has_next ? (const char*)g.Bt + (size_t)nxt.pn * tstep : cB;
        for (int t = 0; t < nt; t += 2) {
            const bool last = (t == nt - 2);
            if constexpr (Epi::MIDHOOK) { if (t == (nt >> 1)) E.mid(acc, cur, wr, wc, fr, fq); }
            const char* a1 = cA + (size_t)(t + 1) * kstep;
            const char* a2 = last ? nA : cA + (size_t)(t + 2) * kstep; const char* b2 = last ? nB : cB + (size_t)(t + 2) * kstep;
            const char* a3 = a2 + kstep; const char* b3 = b2 + kstep;
            if (last && has_next) S.a_ready(nxt);
            if constexpr (SP2) {
            PG8_LDB(B0, 0, 0); PG8_LDB(B1, 0, 1); PG8_SCHED; PG8_LDA(At, 0, 0); PG8_STAGE(PG8_SA(1, 1), a1 + hstep, voffA);
            PG8_WAIT_V(8); PG8_WAIT_L(0); PG8_BAR; PG8_MMA(0, 0, At, B0); PG8_MMA(0, 1, At, B1); PG8_BAR; PG8_SCHED;
            PG8_LDA(At, 0, 1); PG8_STAGE(PG8_SB(0, 0), b2, voffB); PG8_STAGE(PG8_SB(0, 1), b2 + hstep, voffB); PG8_STAGE(PG8_SA(0, 0), a2, voffA);
            PG8_WAIT_V(8); PG8_WAIT_L(0); PG8_BAR; PG8_MMA(1, 0, At, B0); PG8_MMA(1, 1, At, B1); PG8_BAR; PG8_SCHED;
            PG8_LDB(B0, 1, 0); PG8_LDB(B1, 1, 1); PG8_SCHED; PG8_LDA(At, 1, 0); PG8_STAGE(PG8_SA(0, 1), a2 + hstep, voffA);
            PG8_WAIT_V(8); PG8_WAIT_L(0); PG8_BAR; PG8_MMA(0, 0, At, B0); PG8_MMA(0, 1, At, B1); PG8_BAR; PG8_SCHED;
            PG8_LDA(At, 1, 1); PG8_STAGE(PG8_SB(1, 0), b3, voffB); PG8_STAGE(PG8_SB(1, 1), b3 + hstep, voffB); PG8_STAGE(PG8_SA(1, 0), a3, voffA);
            PG8_WAIT_V(8); PG8_WAIT_L(0); PG8_BAR; PG8_MMA(1, 0, At, B0); PG8_MMA(1, 1, At, B1); PG8_BAR; PG8_SCHED;
            } else {
            PG8_LDB(B0, 0, 0); PG8_SCHED; PG8_LDA(At, 0, 0); PG8_STAGE(PG8_SA(1, 1), a1 + hstep, voffA);
            PG8_WAIT_L(8); PG8_BAR; PG8_WAIT_L(0); PG8_MMA(0, 0, At, B0); PG8_BAR; PG8_SCHED;
            PG8_LDB(B1, 0, 1); PG8_STAGE(PG8_SB(0, 0), b2, voffB);
            PG8_BAR; PG8_WAIT_L(0); PG8_MMA(0, 1, At, B1); PG8_BAR;
            PG8_LDA(At, 0, 1); PG8_STAGE(PG8_SA(0, 0), a2, voffA);
            PG8_BAR; PG8_WAIT_L(0); PG8_MMA(1, 0, At, B0); PG8_BAR; PG8_SCHED;
            PG8_STAGE(PG8_SB(0, 1), b2 + hstep, voffB);
            PG8_WAIT_V(6); PG8_BAR; PG8_MMA(1, 1, At, B1); PG8_BAR;
            PG8_LDB(B0, 1, 0); PG8_SCHED; PG8_LDA(At, 1, 0); PG8_STAGE(PG8_SA(0, 1), a2 + hstep, voffA);
            PG8_WAIT_L(8); PG8_BAR; PG8_WAIT_L(0); PG8_MMA(0, 0, At, B0); PG8_BAR; PG8_SCHED;
            PG8_LDB(B1, 1, 1); PG8_STAGE(PG8_SB(1, 0), b3, voffB);
            PG8_BAR; PG8_WAIT_L(0); PG8_MMA(0, 1, At, B1); PG8_BAR;
            PG8_LDA(At, 1, 1); PG8_STAGE(PG8_SA(1, 0), a3, voffA);
            PG8_BAR; PG8_WAIT_L(0); PG8_MMA(1, 0, At, B0); PG8_BAR; PG8_SCHED;
            PG8_STAGE(PG8_SB(1, 1), b3 + hstep, voffB);
            PG8_WAIT_V(6); PG8_BAR; PG8_MMA(1, 1, At, B1); PG8_BAR;
            }
        }
        if constexpr (ALIGN_EPI) { if (wr == 0) PG8_BAR; }
        if constexpr (!Epi::AFTER_DRAIN) { E(acc, cur, wr, wc, fr, fq); S.done(cur); }
        if (!has_next) break;
#pragma unroll
        for (int a = 0; a < 2; ++a)
#pragma unroll
            for (int b = 0; b < 2; ++b)
#pragma unroll
                for (int m = 0; m < 4; ++m)
#pragma unroll
                    for (int n = 0; n < 2; ++n) acc[a][b][m][n] = (f32x4){0.f, 0.f, 0.f, 0.f};
        cur = nxt; cA = nA; cB = nB; ++ui;
        if constexpr (ALIGN_EPI) { if (wr == 1) PG8_BAR; }
    }
    PG8_WAIT_V(0);
    if constexpr (!ALIGN_EPI) { if (wr == 0) PG8_BAR; }
    PG8_BAR;
    if constexpr (Epi::AFTER_DRAIN) { E.fused(acc, cur, wr, wc, fr, fq, lds, wid, lane); S.done(cur); }
#undef PG8_SA
#undef PG8_SB
#undef PG8_STAGE
#undef PG8_LDA
#undef PG8_LDB
#undef PG8_MMA
#undef PG8_WAIT_V
#undef PG8_WAIT_L
#undef PG8_BAR
#undef PG8_SCHED
}
}

#define LAS __attribute__((address_space(3)))
using pg8::bf16_t; using pg8::bf16x8; using pg8::f32x4; using pg8::u32x4; using pg8::Unit;
typedef unsigned u32x2 __attribute__((ext_vector_type(2)));
typedef float f32x2_t __attribute__((ext_vector_type(2)));
typedef __bf16 bf16x2_t __attribute__((ext_vector_type(2)));
__device__ __forceinline__ unsigned cvt_pk_bf16(float lo, float hi) { f32x2_t v = {lo, hi}; bf16x2_t b = __builtin_convertvector(v, bf16x2_t); return __builtin_bit_cast(unsigned, b); }

constexpr int DM = 1024, NB = 4, SEQ = 8192, MTOK = NB * SEQ, CTXL = 256, MCTX = NB * CTXL, MALL = MTOK + MCTX;
constexpr int LTOT = CTXL + SEQ, NCH = LTOT / 16, NMOD = 6 * DM;
constexpr int FFH = 2816, F2 = 2 * FFH, J1 = 1536, J2 = 1280;
constexpr int NTHR = 512, LDS_BYTES = 147456;
constexpr float EPS = 1e-6f;

constexpr size_t MiB = 1u << 20;
constexpr size_t WS_WUP1 = 0, WS_WUP2 = 6 * MiB, WS_WDN1 = 11 * MiB, WS_WDN2 = 14 * MiB;
constexpr size_t WS_WIN = 17 * MiB, WS_WGLU = 24 * MiB, WS_WPA = 24 * MiB + 512 * 1024, WS_WPB = 25 * MiB + 512 * 1024, WS_WOUT = 26 * MiB + 512 * 1024;
constexpr size_t WS_PFRAG = 29 * MiB, WS_QFRAG = 33 * MiB, WS_TFRAG = 37 * MiB, WS_SGUW = 38 * MiB, WS_MOD = 38 * MiB + 512 * 1024, WS_BAR = 39 * MiB;
constexpr size_t WS_HBUF = 40 * MiB, WS_ZB = 106 * MiB, WS_UG = 170 * MiB, WS_GATES = 203 * MiB, WS_SBUF = 331 * MiB, WS_HPREV = 397 * MiB,
                 WS_GY = 462 * MiB, WS_YAB = 40 * MiB, WS_MBUF = 331 * MiB;
constexpr size_t WS_UPB = 106 * MiB, WS_ACT1 = 298 * MiB, WS_ACT2 = 394 * MiB, WS_END = 474 * MiB;

__device__ __forceinline__ float bflo(unsigned w) { return __builtin_bit_cast(float, w << 16); }
__device__ __forceinline__ float bfhi(unsigned w) { return __builtin_bit_cast(float, w & 0xffff0000u); }
__device__ __forceinline__ float bf2f(bf16_t h) { return __builtin_bit_cast(float, ((unsigned)h) << 16); }
__device__ __forceinline__ bf16_t f2bf(float f) { unsigned u = __builtin_bit_cast(unsigned, f); return (bf16_t)((u + 0x7fffu + ((u >> 16) & 1u)) >> 16); }
__device__ __forceinline__ float sigm(float v) { return __builtin_amdgcn_rcpf(1.f + __expf(-v)); }
__device__ __forceinline__ float gelu_t(float x) { const float t = 1.5957691216057308f * (x + 0.044715f * x * x * x); return x * sigm(t); }
__device__ __forceinline__ float wave_sum(float v) {
#pragma unroll
    for (int o = 1; o < 64; o <<= 1) v += __shfl_xor(v, o);
    return v;
}
__device__ __forceinline__ u32x4 pack8(f32x4 a, f32x4 b) { u32x4 w; w.x = cvt_pk_bf16(a[0], a[1]); w.y = cvt_pk_bf16(a[2], a[3]); w.z = cvt_pk_bf16(b[0], b[1]); w.w = cvt_pk_bf16(b[2], b[3]); return w; }
__device__ __forceinline__ void unpack8(u32x4 w, f32x4& a, f32x4& b) { a = (f32x4){bflo(w.x), bfhi(w.x), bflo(w.y), bfhi(w.y)}; b = (f32x4){bflo(w.z), bfhi(w.z), bflo(w.w), bfhi(w.w)}; }
#define LDS_WAIT() asm volatile("s_waitcnt lgkmcnt(0)" ::: "memory")
#define MFMA16(a, b, c) __builtin_amdgcn_mfma_f32_16x16x32_bf16((a), (b), (c), 0, 0, 0)

struct OrderX {
    int nM, nN, nwg, G, c, nExtra, xpm0, xnN;
    __device__ void init(int M, int N, int G_, int c_, int nExtra_ = 0, int xpm0_ = 0, int xnN_ = 1) { nM = M / 256; nN = N / 256; nwg = nM * nN; G = G_; c = c_; nExtra = nExtra_; xpm0 = xpm0_; xnN = xnN_; }
    __device__ bool next(int i, Unit& u) const {
        const long L = (long)i * G + c; if (L >= nwg + nExtra) return false;
        if (L >= nwg) { const int e = (int)L - nwg; u.pm = xpm0 + e / xnN; u.pn = e % xnN; return true; }
        int wgid = (int)L; { const int q = nwg / 8, r = nwg % 8, xcd = wgid % 8, off = wgid / 8; wgid = (xcd < r ? xcd * (q + 1) : r * (q + 1) + (xcd - r) * q) + off; }
        const int nig = 8 * nN, gid = wgid / nig, fm = gid * 8, gsz = (nM - fm) < 8 ? (nM - fm) : 8;
        u.pm = fm + ((wgid % nig) % gsz); u.pn = (wgid % nig) / gsz; return true;
    }
    __device__ __forceinline__ void a_ready(const Unit&) const {}
    __device__ __forceinline__ void done(const Unit&) const {}
};

#define EPI_HEAD const int row0 = u.pm * 256 + wr * 64 + fr; const int col0 = u.pn * 256 + wc * 32 + 8 * fq;
#define EPI_LOOP _Pragma("unroll") for (int ai = 0; ai < 2; ++ai) _Pragma("unroll") for (int m = 0; m < 4; ++m) _Pragma("unroll") for (int bj = 0; bj < 2; ++bj)

struct EpiIn {
    static constexpr bool PERM = true, AFTER_DRAIN = false, MIDHOOK = false;
    bf16_t* ug; bf16_t* zb; bf16_t* gates; const float* bgate;
    __device__ __forceinline__ void operator()(const f32x4 (&acc)[2][2][4][2], const Unit& u, int wr, int wc, int fr, int fq) const {
        EPI_HEAD
        if (u.pn < 2) {
            EPI_LOOP { const int row = row0 + ai * 128 + m * 16, c = col0 + bj * 128;
                int b, pos; if (row < MTOK) { b = row >> 13; pos = CTXL + (row & (SEQ - 1)); } else { const int rr = row - MTOK; b = rr >> 8; pos = rr & (CTXL - 1); }
                const int g = c >> 4, hh = c & 15;
                *(u32x4*)(ug + ((size_t)(b * 32 + g) * LTOT + pos) * 16 + hh) = pack8(acc[ai][bj][m][0], acc[ai][bj][m][1]); }
        } else if (u.pn < 6) {
            EPI_LOOP { const int row = row0 + ai * 128 + m * 16, c = col0 + bj * 128 - 512;
                f32x4 v0 = acc[ai][bj][m][0], v1 = acc[ai][bj][m][1];
#pragma unroll
                for (int e = 0; e < 4; ++e) { v0[e] = gelu_t(v0[e]); v1[e] = gelu_t(v1[e]); }
                *(u32x4*)(zb + (size_t)row * 1024 + c) = pack8(v0, v1); }
        } else {
            f32x4 bv[2][2];
#pragma unroll
            for (int bj = 0; bj < 2; ++bj) { bv[bj][0] = *(const f32x4*)(bgate + col0 + bj * 128 - 1536); bv[bj][1] = *(const f32x4*)(bgate + col0 + bj * 128 - 1536 + 4); }
            EPI_LOOP { const int row = row0 + ai * 128 + m * 16, c = col0 + bj * 128 - 1536;
                f32x4 v0 = acc[ai][bj][m][0] + bv[bj][0], v1 = acc[ai][bj][m][1] + bv[bj][1];
#ifndef DBG_NOSIG
#pragma unroll
                for (int e = 0; e < 4; ++e) { v0[e] = sigm(v0[e]); v1[e] = sigm(v1[e]); }
#endif
                __builtin_nontemporal_store(pack8(v0, v1), (u32x4*)(gates + (size_t)row * 2048 + c)); }
        }
    }
};
struct EpiGlu {
    static constexpr bool PERM = true, AFTER_DRAIN = false, MIDHOOK = false;
    const bf16_t* gy; bf16_t* ya; const float* bias;
    __device__ __forceinline__ void operator()(const f32x4 (&acc)[2][2][4][2], const Unit& u, int wr, int wc, int fr, int fq) const {
        EPI_HEAD
        f32x4 bv[2][2];
#pragma unroll
        for (int bj = 0; bj < 2; ++bj) { bv[bj][0] = *(const f32x4*)(bias + col0 + bj * 128); bv[bj][1] = *(const f32x4*)(bias + col0 + bj * 128 + 4); }
        EPI_LOOP { const int row = row0 + ai * 128 + m * 16, c = col0 + bj * 128;
            f32x4 g0, g1; unpack8(*(const u32x4*)(gy + (size_t)row * 512 + c), g0, g1);
            f32x4 v0 = acc[ai][bj][m][0] + bv[bj][0], v1 = acc[ai][bj][m][1] + bv[bj][1];
#pragma unroll
            for (int e = 0; e < 4; ++e) { v0[e] = g0[e] * sigm(v0[e]); v1[e] = g1[e] * sigm(v1[e]); }
            *(u32x4*)(ya + (size_t)row * 1024 + c) = pack8(v0, v1); }
    }
};
struct EpiMerge {
    static constexpr bool PERM = true, AFTER_DRAIN = false, MIDHOOK = true;
    const bf16_t* gates; bf16_t* mb;
    __device__ __forceinline__ void mid(f32x4 (&acc)[2][2][4][2], const Unit& u, int wr, int wc, int fr, int fq) const {
        EPI_HEAD
        const char* gb_ = (const char*)gates;
        unsigned base = ((unsigned)row0 * 2048u + (unsigned)col0) * 2u;
        asm volatile("" : "+v"(base));
        EPI_LOOP { const unsigned off = base + (unsigned)(ai * 128 + m * 16) * 4096u + (unsigned)bj * 256u;
            f32x4 a0, a1, b0, b1; unpack8(*(const u32x4*)(gb_ + off), a0, a1); unpack8(*(const u32x4*)(gb_ + off + 2048), b0, b1);
#pragma unroll
            for (int e = 0; e < 4; ++e) { acc[ai][bj][m][0][e] *= a0[e] * __builtin_amdgcn_rcpf(b0[e]); acc[ai][bj][m][1][e] *= a1[e] * __builtin_amdgcn_rcpf(b1[e]); }
            if (bj == 1 && (m & 1)) __builtin_amdgcn_sched_barrier(0); }
    }
    __device__ __forceinline__ void operator()(const f32x4 (&acc)[2][2][4][2], const Unit& u, int wr, int wc, int fr, int fq) const {
        EPI_HEAD
        EPI_LOOP { const int row = row0 + ai * 128 + m * 16, c = col0 + bj * 128;
            f32x4 b0, b1; unpack8(*(const u32x4*)(gates + (size_t)row * 2048 + 1024 + c), b0, b1);
            *(u32x4*)(mb + (size_t)row * 1024 + c) = pack8(b0 * acc[ai][bj][m][0], b1 * acc[ai][bj][m][1]); }
    }
};
struct EpiRes {
    static constexpr bool PERM = true, AFTER_DRAIN = false, MIDHOOK = false;
    const float* base; float* out; const float* gate;
    __device__ __forceinline__ void operator()(const f32x4 (&acc)[2][2][4][2], const Unit& u, int wr, int wc, int fr, int fq) const {
        EPI_HEAD
        const int b = (u.pm * 256) >> 13;
        f32x4 gv[2][2];
#pragma unroll
        for (int bj = 0; bj < 2; ++bj) { gv[bj][0] = *(const f32x4*)(gate + b * NMOD + col0 + bj * 128); gv[bj][1] = *(const f32x4*)(gate + b * NMOD + col0 + bj * 128 + 4); }
        EPI_LOOP { const int row = row0 + ai * 128 + m * 16, c = col0 + bj * 128;
            const f32x4 x0 = *(const f32x4*)(base + (size_t)row * 1024 + c), x1 = *(const f32x4*)(base + (size_t)row * 1024 + c + 4);
            *(f32x4*)(out + (size_t)row * 1024 + c) = x0 + gv[bj][0] * acc[ai][bj][m][0]; *(f32x4*)(out + (size_t)row * 1024 + c + 4) = x1 + gv[bj][1] * acc[ai][bj][m][1]; }
    }
};
struct EpiPlain {
    static constexpr bool PERM = true, AFTER_DRAIN = false, MIDHOOK = false;
    bf16_t* O; int ldc;
    __device__ __forceinline__ void operator()(const f32x4 (&acc)[2][2][4][2], const Unit& u, int wr, int wc, int fr, int fq) const {
        EPI_HEAD
        EPI_LOOP { const int row = row0 + ai * 128 + m * 16, c = col0 + bj * 128;
            *(u32x4*)(O + (size_t)row * ldc + c) = pack8(acc[ai][bj][m][0], acc[ai][bj][m][1]); }
    }
};

__device__ __forceinline__ void tr_item(const float* W, int ldw, int k0s, int n0s, bf16_t* WT, int dpitch, int k0d, int n0d, LAS float* scr, int lane) {
    f32x4 t[8];
#pragma unroll
    for (int i = 0; i < 8; ++i) { const int kk = (lane >> 3) + 8 * i; t[i] = *(const f32x4*)(W + (size_t)(k0s + kk) * ldw + n0s + (lane & 7) * 4); }
#pragma unroll
    for (int i = 0; i < 8; ++i) { const int kk = (lane >> 3) + 8 * i; LAS float* q = scr + kk * 33 + (lane & 7) * 4; q[0] = t[i][0]; q[1] = t[i][1]; q[2] = t[i][2]; q[3] = t[i][3]; }
    LDS_WAIT();
    const int c = lane & 7;
#pragma unroll
    for (int j = 0; j < 4; ++j) { const int n = (lane >> 3) + 8 * j; const LAS float* s = scr + (8 * c) * 33 + n;
        u32x4 o; o.x = cvt_pk_bf16(s[0 * 33], s[1 * 33]); o.y = cvt_pk_bf16(s[2 * 33], s[3 * 33]); o.z = cvt_pk_bf16(s[4 * 33], s[5 * 33]); o.w = cvt_pk_bf16(s[6 * 33], s[7 * 33]);
        *(u32x4*)(WT + (size_t)(n0d + n) * dpitch + k0d + 8 * c) = o; }
    LDS_WAIT();
}
__device__ __forceinline__ bool tr_job(int& r, const float* W, int ldw, int ks, int ns, int nK, int nN, bf16_t* WT, int dp, int nd0, LAS float* scr, int lane, int kd0 = 0) {
    const int nb = nN / 32, items = (nK / 64) * nb;
    if (r < items) { const int kb = r / nb, nbi = r % nb; tr_item(W, ldw, ks + 64 * kb, ns + 32 * nbi, WT, dp, kd0 + 64 * kb, nd0 + 32 * nbi, scr, lane); return true; }
    r -= items; return false;
}

struct P0Args { const float *c, *cctx, *wada, *bada, *w_in, *w_glu, *w_pa, *w_pb, *w_out, *w_up, *w_down, *sgu_w;
                const float *a_re, *a_im, *logstep, *b_re, *b_im, *c_re, *c_im, *dskip; };

__device__ __forceinline__ void p0_gemv_item(int it, const P0Args& A, float* mod, LAS unsigned char* lds, int tid, int lane, int wave) {
    LAS float* sv = (LAS float*)(lds); LAS float* red = (LAS float*)(lds + 24576);
    for (int i = tid; i < 5 * 1024; i += NTHR) { const int r = i >> 10, k = i & 1023; const float v = r < 4 ? A.c[r * 1024 + k] : A.cctx[k]; sv[i] = v / (1.f + expf(-v)); }
    __syncthreads();
    const int n = it * 64 + lane, k0 = wave * 128;
    float a0 = 0.f, a1 = 0.f, a2 = 0.f, a3 = 0.f, a4 = 0.f;
#pragma unroll 32
    for (int kk = 0; kk < 128; ++kk) { const float w = A.wada[(size_t)(k0 + kk) * NMOD + n];
        a0 += sv[k0 + kk] * w; a1 += sv[1024 + k0 + kk] * w; a2 += sv[2048 + k0 + kk] * w; a3 += sv[3072 + k0 + kk] * w; a4 += sv[4096 + k0 + kk] * w; }
    red[(wave * 5 + 0) * 64 + lane] = a0; red[(wave * 5 + 1) * 64 + lane] = a1; red[(wave * 5 + 2) * 64 + lane] = a2; red[(wave * 5 + 3) * 64 + lane] = a3; red[(wave * 5 + 4) * 64 + lane] = a4;
    __syncthreads();
    if (tid < 320) { const int r = tid >> 6, l = tid & 63; float s = 0.f;
#pragma unroll
        for (int w = 0; w < 8; ++w) s += red[(w * 5 + r) * 64 + l];
        mod[r * NMOD + it * 64 + l] = s + A.bada[it * 64 + l]; }
    __syncthreads();
}

__device__ __forceinline__ void p0_s5_item(int dg, const P0Args& A, bf16_t* pfrag, bf16_t* qfrag, bf16_t* tfrag, LAS unsigned char* lds, int tid) {
    const int d = dg >> 5, g = dg & 31;
    LAS float* apr = (LAS float*)lds;
    LAS float* api = apr + 17 * 64;
    LAS float* bbr = api + 17 * 64;
    LAS float* bbi = bbr + 1024;
    LAS float* cr = bbi + 1024;
    LAS float* ci = cr + 1024;
    LAS float* T = ci + 1024;
    const float dt = expf(A.logstep[dg]);
    const float* are = A.a_re + dg * 64; const float* aim = A.a_im + dg * 64;
    for (int i = tid; i < 17 * 64; i += NTHR) { const int k = i >> 6, n = i & 63; const float kd = (float)k * dt; const float mag = expf(kd * are[n]); const float ang = kd * aim[n];
        apr[i] = mag * cosf(ang); api[i] = mag * sinf(ang); }
    for (int i = tid; i < 1024; i += NTHR) { cr[i] = A.c_re[dg * 1024 + i]; ci[i] = A.c_im[dg * 1024 + i]; }
    __syncthreads();
    for (int i = tid; i < 1024; i += NTHR) { const int n = i >> 4; const float ar = are[n], ai = aim[n]; const float p = apr[64 + n] - 1.f, q = api[64 + n]; const float den = ar * ar + ai * ai;
        const float kr = (p * ar + q * ai) / den, ki = (q * ar - p * ai) / den; const float br = A.b_re[dg * 1024 + i], bi = A.b_im[dg * 1024 + i];
        bbr[i] = kr * br - ki * bi; bbi[i] = kr * bi + ki * br; }
    __syncthreads();
    if (tid < 256) { const int lag = tid >> 4, ho = tid & 15; f32x4 s[4];
#pragma unroll
        for (int q = 0; q < 4; ++q) s[q] = (f32x4){0.f, 0.f, 0.f, 0.f};
        for (int n = 0; n < 64; ++n) { const float c_r = cr[ho * 64 + n], c_i = ci[ho * 64 + n], p_r = apr[lag * 64 + n], p_i = api[lag * 64 + n];
            const float qr = c_r * p_r - c_i * p_i, qi = c_r * p_i + c_i * p_r;
#pragma unroll
            for (int q = 0; q < 4; ++q) { const f32x4 b_r = *(const LAS f32x4*)(bbr + n * 16 + q * 4), b_i = *(const LAS f32x4*)(bbi + n * 16 + q * 4); s[q] += b_r * qr - b_i * qi; } }
#pragma unroll
        for (int q = 0; q < 4; ++q) *(LAS f32x4*)(T + tid * 16 + q * 4) = s[q];
        if (d == 0 && lag == 0) T[tid * 16 + ho] += A.dskip[g * 16 + ho]; }
    for (int f = tid; f < 4096; f += NTHR) { const int nt = f >> 9, ks = (f >> 6) & 7, ln = f & 63; const int col = nt * 16 + (ln & 15), kg = ln >> 4; const int jtok = ks * 2 + (kg >> 1), h0 = (kg & 1) * 8;
        const int n = col & 63, im = col >> 6; const int pw = d == 0 ? 15 - jtok : jtok; const float p_r = apr[pw * 64 + n], p_i = api[pw * 64 + n];
        float v[8];
#pragma unroll
        for (int e = 0; e < 8; ++e) { const float b_r = bbr[n * 16 + h0 + e], b_i = bbi[n * 16 + h0 + e]; v[e] = im ? (p_r * b_i + p_i * b_r) : (p_r * b_r - p_i * b_i); }
        u32x4 o; o.x = cvt_pk_bf16(v[0], v[1]); o.y = cvt_pk_bf16(v[2], v[3]); o.z = cvt_pk_bf16(v[4], v[5]); o.w = cvt_pk_bf16(v[6], v[7]);
        *(u32x4*)(pfrag + ((size_t)dg * 4096 + f) * 8) = o; }
    for (int f = tid; f < 4096; f += NTHR) { const int jout = f >> 8, ks = (f >> 6) & 3, ln = f & 63; const int ho = ln & 15, kg = ln >> 4; const int pw = d == 0 ? jout + 1 : 16 - jout;
        float v[8];
#pragma unroll
        for (int e = 0; e < 8; ++e) { const int kk = ks * 32 + kg * 8 + e, n = kk & 63, im = kk >> 6; const float c_r = cr[ho * 64 + n], c_i = ci[ho * 64 + n], p_r = apr[pw * 64 + n], p_i = api[pw * 64 + n];
            v[e] = im ? -(c_r * p_i + c_i * p_r) : (c_r * p_r - c_i * p_i); }
        u32x4 o; o.x = cvt_pk_bf16(v[0], v[1]); o.y = cvt_pk_bf16(v[2], v[3]); o.z = cvt_pk_bf16(v[4], v[5]); o.w = cvt_pk_bf16(v[6], v[7]);
        *(u32x4*)(qfrag + ((size_t)dg * 4096 + f) * 8) = o; }
    __syncthreads();
    for (int f = tid; f < 1024; f += NTHR) { const int dd = f >> 6, ln = f & 63; const int ho = ln & 15, kg = ln >> 4; const int lag = d == 0 ? dd - (kg >> 1) : dd - 1 + (kg >> 1); const int hi0 = (kg & 1) * 8;
        float v[8];
#pragma unroll
        for (int e = 0; e < 8; ++e) v[e] = lag >= 0 ? T[(lag & 15) * 256 + ho * 16 + hi0 + e] : 0.f;
        u32x4 o; o.x = cvt_pk_bf16(v[0], v[1]); o.y = cvt_pk_bf16(v[2], v[3]); o.z = cvt_pk_bf16(v[4], v[5]); o.w = cvt_pk_bf16(v[6], v[7]);
        *(u32x4*)(tfrag + ((size_t)dg * 1024 + f) * 8) = o; }
    __syncthreads();
}

__device__ __forceinline__ void mod_rows(const float* xs, const float* ctx, int nrows, const float* gamma, const float* mod, int shoff, int scoff, bf16_t* out, int gw, int NGW, int lane) {
    for (int mb = gw; mb < nrows; mb += 4 * NGW) {
        f32x4 v[4][4];
#pragma unroll
        for (int q = 0; q < 4; ++q) { const int m = (mb + q * NGW < nrows) ? mb + q * NGW : mb; const float* xr = (m < MTOK) ? xs + (size_t)m * DM : ctx + (size_t)(m - MTOK) * DM;
#pragma unroll
            for (int j = 0; j < 4; ++j) v[q][j] = __builtin_nontemporal_load((const f32x4*)xr + lane + 64 * j); }
#pragma unroll
        for (int q = 0; q < 4; ++q) { const int m = mb + q * NGW; float s = 0.f;
#pragma unroll
            for (int j = 0; j < 4; ++j) s += (v[q][j][0] * v[q][j][0] + v[q][j][1] * v[q][j][1]) + (v[q][j][2] * v[q][j][2] + v[q][j][3] * v[q][j][3]);
            const float rstd = rsqrtf(wave_sum(s) * (1.f / DM) + EPS);
            if (m < nrows) { const int mr = (m < MTOK) ? (m >> 13) : 4;
#pragma unroll
                for (int j = 0; j < 4; ++j) { const int col = 4 * (lane + 64 * j);
                    const f32x4 g4 = *(const f32x4*)(gamma + col), sc4 = *(const f32x4*)(mod + mr * NMOD + scoff + col), sh4 = *(const f32x4*)(mod + mr * NMOD + shoff + col);
                    const f32x4 o = (v[q][j] * rstd) * g4 * (sc4 + 1.f) + sh4; u32x2 w; w.x = cvt_pk_bf16(o[0], o[1]); w.y = cvt_pk_bf16(o[2], o[3]); *(u32x2*)(out + (size_t)m * DM + col) = w; } } }
    }
}
__device__ __forceinline__ void mod_rows2(const float* xs, const float* ctx, int nrows, const float* gamma, const float* mod, int shoff, int scoff, bf16_t* out, int gw, int NGW, int lane) {
    for (int mb = gw; mb < nrows; mb += 4 * NGW) {
        f32x4 v[4][4];
#pragma unroll
        for (int q = 0; q < 4; ++q) { const int m = (mb + q * NGW < nrows) ? mb + q * NGW : mb; const float* xr = (m < MTOK) ? xs + (size_t)m * DM : ctx + (size_t)(m - MTOK) * DM;
#pragma unroll
            for (int j = 0; j < 4; ++j) v[q][j] = __builtin_nontemporal_load((const f32x4*)xr + lane + 64 * j); }
#pragma unroll
        for (int q = 0; q < 4; ++q) { const int m = mb + q * NGW; float s = 0.f;
#pragma unroll
            for (int j = 0; j < 4; ++j) s += (v[q][j][0] * v[q][j][0] + v[q][j][1] * v[q][j][1]) + (v[q][j][2] * v[q][j][2] + v[q][j][3] * v[q][j][3]);
            const float rstd = rsqrtf(wave_sum(s) * (1.f / DM) + EPS);
            if (m < nrows) { const int mr = (m < MTOK) ? (m >> 13) : 4;
#pragma unroll
                for (int j = 0; j < 4; ++j) { const int col = 4 * (lane + 64 * j);
                    const f32x4 g4 = *(const f32x4*)(gamma + col), sc4 = *(const f32x4*)(mod + mr * NMOD + scoff + col), sh4 = *(const f32x4*)(mod + mr * NMOD + shoff + col);
                    const f32x4 o = (v[q][j] * rstd) * g4 * (sc4 + 1.f) + sh4; u32x2 w; w.x = cvt_pk_bf16(o[0], o[1]); w.y = cvt_pk_bf16(o[2], o[3]); *(u32x2*)(out + (size_t)m * DM + col) = w; } } }
    }
}

constexpr int UCTX_OFF = 65536 + 16896;
#define CMULADD(hr, hi, ar, ai, sr, si) do { const float _nr = (ar) * (hr) - (ai) * (hi) + (sr), _ni = (ar) * (hi) + (ai) * (hr) + (si); (hr) = _nr; (hi) = _ni; } while (0)
__device__ __forceinline__ void s5_load_act(bf16x8 (&act)[8], int mt, LAS unsigned char* lds, const bf16_t* useq, int lane) {
    const int chunk = mt * 16 + (lane & 15), fq = lane >> 4;
    if (mt == 0) {
#pragma unroll
        for (int ks = 0; ks < 8; ++ks) act[ks] = *(const LAS bf16x8*)(lds + UCTX_OFF + (chunk * 256 + ks * 32 + fq * 8) * 2);
    } else if (mt > 0) {
#pragma unroll
        for (int ks = 0; ks < 8; ++ks) act[ks] = *(const bf16x8*)(useq + (size_t)chunk * 256 + ks * 32 + fq * 8);
    }
}
template <bool WRITE>
__device__ __forceinline__ void s5_tile(const bf16x8 (&act)[8], int mt, int d, LAS unsigned char* lds, bf16_t* hp, const float (&a16r)[4], const float (&a16i)[4], const float (&A4r)[4], const float (&A4i)[4],
                                        float (&Hr)[4], float (&Hi)[4], int lane) {
    const int n16 = lane & 15, fq = lane >> 4;
    const int qpos = d ? 3 - fq : fq;
#pragma unroll
    for (int t = 0; t < 4; ++t) {
        f32x4 are = {0.f, 0.f, 0.f, 0.f}, aim = {0.f, 0.f, 0.f, 0.f};
#pragma unroll
        for (int ks = 0; ks < 8; ++ks) { are = MFMA16(act[ks], *(const LAS bf16x8*)(lds + ((t * 8 + ks) * 64 + lane) * 16), are);
                                         aim = MFMA16(act[ks], *(const LAS bf16x8*)(lds + (((t + 4) * 8 + ks) * 64 + lane) * 16), aim); }
        float sr[4], si[4];
#pragma unroll
        for (int k = 0; k < 4; ++k) { sr[k] = d ? are[3 - k] : are[k]; si[k] = d ? aim[3 - k] : aim[k]; }
        float gr = 0.f, gi = 0.f;
#pragma unroll
        for (int k = 0; k < 4; ++k) CMULADD(gr, gi, a16r[t], a16i[t], sr[k], si[k]);
        float run_r = Hr[t], run_i = Hi[t], my_r = 0.f, my_i = 0.f;
#pragma unroll
        for (int pos = 0; pos < 4; ++pos) { const int p = d ? 3 - pos : pos; const float pr = __shfl(gr, n16 + 16 * p), pi = __shfl(gi, n16 + 16 * p);
            if (pos == qpos) { my_r = run_r; my_i = run_i; }
            CMULADD(run_r, run_i, A4r[t], A4i[t], pr, pi); }
        Hr[t] = run_r; Hi[t] = run_i;
        if (WRITE) {
            float h_r = my_r, h_i = my_i; const int n = t * 16 + n16;
#pragma unroll
            for (int k = 0; k < 4; ++k) { const int cc = mt * 16 + fq * 4 + (d ? 3 - k : k);
                hp[(size_t)cc * 128 + n] = f2bf(h_r); hp[(size_t)cc * 128 + 64 + n] = f2bf(h_i);
                CMULADD(h_r, h_i, a16r[t], a16i[t], sr[k], si[k]); }
        }
    }
}

__device__ __forceinline__ void s5ab_item(int item, LAS unsigned char* lds, const bf16_t* pfrag, const bf16_t* ug, const bf16_t* hbuf, const bf16_t* win, bf16_t* hprev,
                                          const float* a_re, const float* a_im, const float* logstep, int tid, int lane, int wave) {
    const int d = item >> 7, b = (item >> 5) & 3, g = item & 31, dg = d * 32 + g;
    { const u32x4* src = (const u32x4*)(pfrag + (size_t)dg * 32768);
      for (int i = tid; i < 4096; i += NTHR) ((LAS u32x4*)lds)[i] = src[i]; }
    const bf16_t* useq = ug + (size_t)(b * 32 + g) * LTOT * 16;
    bf16_t* hp = hprev + (size_t)item * NCH * 128;
    LAS float* TT = (LAS float*)(lds + 65536);
    float a16r[4], a16i[4], A4r[4], A4i[4], ATr[4], ATi[4];
    { const float dt = expf(logstep[dg]);
#pragma unroll
      for (int t = 0; t < 4; ++t) { const int n = t * 16 + (lane & 15); const float k16 = 16.f * dt; const float mag = expf(k16 * a_re[dg * 64 + n]); const float ang = k16 * a_im[dg * 64 + n];
          const float r1 = mag * cosf(ang), i1 = mag * sinf(ang); a16r[t] = r1; a16i[t] = i1;
          const float r2 = r1 * r1 - i1 * i1, i2 = 2.f * r1 * i1; const float r4 = r2 * r2 - i2 * i2, i4 = 2.f * r2 * i2; A4r[t] = r4; A4i[t] = i4;
          const float r8 = r4 * r4 - i4 * i4, i8 = 2.f * r4 * i4; ATr[t] = r8 * r8 - i8 * i8; ATi[t] = 2.f * r8 * i8; } }
    for (int mtc = wave; mtc < 16; mtc += 8) {
        const bf16_t* ap = hbuf + ((size_t)(MTOK + b * 256 + mtc * 16 + (lane & 15))) * 1024 + (lane >> 4) * 8;
        const bf16_t* bp = win + ((size_t)(g * 16 + (lane & 15))) * 1024 + (lane >> 4) * 8;
        f32x4 acc = {0.f, 0.f, 0.f, 0.f};
#pragma unroll 16
        for (int ks = 0; ks < 32; ++ks) acc = MFMA16(*(const bf16x8*)(ap + ks * 32), *(const bf16x8*)(bp + ks * 32), acc);
        LAS bf16_t* uc = (LAS bf16_t*)(lds + UCTX_OFF);
#pragma unroll
        for (int r = 0; r < 4; ++r) uc[(mtc * 16 + (lane >> 4) * 4 + r) * 16 + (lane & 15)] = f2bf(acc[r]);
    }
    __syncthreads();
#define S5_NTH(k) (d == 0 ? ((wave + 8 * (k)) < NCH / 16 ? wave + 8 * (k) : -1) : (wave == 0 ? ((k) == 0 ? 0 : ((k) <= 4 ? 40 - 8 * (k) : -1)) : ((k) <= 3 ? 24 + wave - 8 * (k) : -1)))
    { bf16x8 actA[8], actB[8]; int mt = S5_NTH(0); s5_load_act(actA, mt, lds, useq, lane);
      for (int k = 0; mt >= 0; ++k) { const int nx = S5_NTH(k + 1); s5_load_act(actB, nx, lds, useq, lane);
        float Hr[4] = {0.f, 0.f, 0.f, 0.f}, Hi[4] = {0.f, 0.f, 0.f, 0.f};
        s5_tile<false>(actA, mt, d, lds, hp, a16r, a16i, A4r, A4i, Hr, Hi, lane);
        if (lane < 16) {
#pragma unroll
            for (int t = 0; t < 4; ++t) { TT[(mt * 64 + t * 16 + lane) * 2] = Hr[t]; TT[(mt * 64 + t * 16 + lane) * 2 + 1] = Hi[t]; } }
#pragma unroll
        for (int ks = 0; ks < 8; ++ks) actA[ks] = actB[ks];
        mt = nx; } }
    __syncthreads();
    { float Hr[4] = {0.f, 0.f, 0.f, 0.f}, Hi[4] = {0.f, 0.f, 0.f, 0.f};
      bf16x8 actA[8]; int k = 0, mine = S5_NTH(0); s5_load_act(actA, mine, lds, useq, lane);
      for (int idx = 0; idx < NCH / 16; ++idx) { const int mt = d ? (idx == 0 ? 0 : NCH / 16 - idx) : idx;
          if (mt == mine) { float Tr[4], Ti[4];
#pragma unroll
              for (int t = 0; t < 4; ++t) { Tr[t] = Hr[t]; Ti[t] = Hi[t]; }
              bf16x8 actB[8]; ++k; const int nx = S5_NTH(k); s5_load_act(actB, nx, lds, useq, lane);
              s5_tile<true>(actA, mt, d, lds, hp, a16r, a16i, A4r, A4i, Tr, Ti, lane);
#pragma unroll
              for (int ks = 0; ks < 8; ++ks) actA[ks] = actB[ks];
              mine = nx; }
#pragma unroll
          for (int t = 0; t < 4; ++t) { const float sr = TT[(mt * 64 + t * 16 + (lane & 15)) * 2], si = TT[(mt * 64 + t * 16 + (lane & 15)) * 2 + 1]; CMULADD(Hr[t], Hi[t], ATr[t], ATi[t], sr, si); } } }
#undef S5_NTH
    __syncthreads();
}

constexpr int VTP = 136;
__device__ __forceinline__ void sgu_item(int chunk, LAS unsigned char* lds, const bf16_t* zb, const bf16_t* sguw16, const float* sgub, const float* lng, const float* lnb, bf16_t* yb, int tid, int lane, int wave) {
    LAS bf16_t* vT = (LAS bf16_t*)lds;
    float gl[8], bl[8];
#pragma unroll
    for (int e = 0; e < 8; ++e) { gl[e] = lng[lane + 64 * e]; bl[e] = lnb[lane + 64 * e]; }
    for (int ib = 0; ib < 16; ib += 4) {
        float v[4][8];
#pragma unroll
        for (int q = 0; q < 4; ++q) { const bf16_t* zr = zb + (size_t)(chunk * 128 + wave * 16 + ib + q) * 1024 + 512;
#pragma unroll
            for (int e = 0; e < 8; ++e) v[q][e] = bf2f(zr[lane + 64 * e]); }
#pragma unroll
        for (int q = 0; q < 4; ++q) { const int p = wave * 16 + ib + q; float s = 0.f;
#pragma unroll
            for (int e = 0; e < 8; ++e) s += v[q][e];
            const float mean = wave_sum(s) * (1.f / 512.f); float s2 = 0.f;
#pragma unroll
            for (int e = 0; e < 8; ++e) { v[q][e] -= mean; s2 += v[q][e] * v[q][e]; }
            const float rstd = rsqrtf(wave_sum(s2) * (1.f / 512.f) + EPS);
#pragma unroll
            for (int e = 0; e < 8; ++e) vT[(lane + 64 * e) * VTP + p] = f2bf(v[q][e] * rstd * gl[e] + bl[e]); }
    }
    __syncthreads();
    const int gg = wave, i_ = lane & 15, kg = lane >> 4;
    bf16x8 vf[4][4];
#pragma unroll
    for (int dt = 0; dt < 4; ++dt)
#pragma unroll
        for (int ks = 0; ks < 4; ++ks) vf[dt][ks] = *(const LAS bf16x8*)(vT + (gg * 64 + dt * 16 + i_) * VTP + ks * 32 + kg * 8);
    bf16x8 wf[4];
#pragma unroll
    for (int ks = 0; ks < 4; ++ks) wf[ks] = *(const bf16x8*)(sguw16 + ((size_t)(gg * 128 + i_)) * 128 + ks * 32 + kg * 8);
    for (int qt = 0; qt < 8; ++qt) { const int q = qt * 16 + i_; const size_t row = (size_t)chunk * 128 + q;
        bf16x8 wn[4]; u32x2 uz[4];
#pragma unroll
        for (int ks = 0; ks < 4; ++ks) wn[ks] = *(const bf16x8*)(sguw16 + ((size_t)(gg * 128 + ((qt + 1) & 7) * 16 + i_)) * 128 + ks * 32 + kg * 8);
#pragma unroll
        for (int dt = 0; dt < 4; ++dt) uz[dt] = *(const u32x2*)(zb + row * 1024 + gg * 64 + dt * 16 + kg * 4);
        const float bias = sgub[gg * 128 + q];
        f32x4 acc[4];
#pragma unroll
        for (int dt = 0; dt < 4; ++dt) { acc[dt] = (f32x4){0.f, 0.f, 0.f, 0.f};
#pragma unroll
            for (int ks = 0; ks < 4; ++ks) acc[dt] = MFMA16(vf[dt][ks], wf[ks], acc[dt]); }
#pragma unroll
        for (int dt = 0; dt < 4; ++dt) { const int c = gg * 64 + dt * 16 + kg * 4;
            u32x2 w; w.x = cvt_pk_bf16(bflo(uz[dt].x) * (acc[dt][0] + bias), bfhi(uz[dt].x) * (acc[dt][1] + bias)); w.y = cvt_pk_bf16(bflo(uz[dt].y) * (acc[dt][2] + bias), bfhi(uz[dt].y) * (acc[dt][3] + bias));
            *(u32x2*)(yb + row * 1024 + c) = w; }
#pragma unroll
        for (int ks = 0; ks < 4; ++ks) wf[ks] = wn[ks];
    }
    __syncthreads();
}

__device__ __forceinline__ void s5c_item(int item, LAS unsigned char* lds, const bf16_t* qfrag, const bf16_t* tfrag, const bf16_t* ug, const bf16_t* hprev, bf16_t* gy, int tid, int lane, int wave) {
    const int b = item >> 7, g = (item >> 2) & 31, quarter = item & 3;
    const bf16_t* useq = ug + (size_t)(b * 32 + g) * LTOT * 16;
    const int kg = lane >> 4;
    const int chunk = 16 + (quarter * 8 + wave) * 16 + (lane & 15);
    bf16x8 U[8];
#pragma unroll
    for (int ks = 0; ks < 8; ++ks) U[ks] = *(const bf16x8*)(useq + (size_t)chunk * 256 + ks * 32 + kg * 8);
    f32x4 acc[16];
#pragma unroll
    for (int j = 0; j < 16; ++j) acc[j] = (f32x4){0.f, 0.f, 0.f, 0.f};
#pragma unroll
    for (int d = 0; d < 2; ++d) {
        __syncthreads();
        { const u32x4* src = (const u32x4*)(qfrag + (size_t)(d * 32 + g) * 32768);
          for (int i = tid; i < 4096; i += NTHR) ((LAS u32x4*)lds)[i] = src[i];
          const u32x4* srt = (const u32x4*)(tfrag + (size_t)(d * 32 + g) * 8192);
          for (int i = tid; i < 1024; i += NTHR) ((LAS u32x4*)(lds + 65536))[i] = srt[i]; }
        const bf16_t* hp = hprev + ((size_t)((d * 4 + b) * 32 + g) * NCH + chunk) * 128;
        bf16x8 H[4];
#pragma unroll
        for (int ks = 0; ks < 4; ++ks) H[ks] = *(const bf16x8*)(hp + ks * 32 + kg * 8);
        __syncthreads();
#pragma unroll
        for (int jout = 0; jout < 16; ++jout) {
#pragma unroll
            for (int ks = 0; ks < 4; ++ks) acc[jout] = MFMA16(*(const LAS bf16x8*)(lds + ((jout * 4 + ks) * 64 + lane) * 16), H[ks], acc[jout]);
            if (d == 0) {
#pragma unroll
                for (int ks = 0; ks < 8; ++ks) if (2 * ks <= jout) acc[jout] = MFMA16(*(const LAS bf16x8*)(lds + 65536 + ((jout - 2 * ks) * 64 + lane) * 16), U[ks], acc[jout]);
            } else {
#pragma unroll
                for (int ks = 0; ks < 8; ++ks) if (2 * ks + 1 >= jout) acc[jout] = MFMA16(*(const LAS bf16x8*)(lds + 65536 + ((2 * ks - jout + 1) * 64 + lane) * 16), U[ks], acc[jout]);
            }
        }
    }
    const size_t rowb = (size_t)b * SEQ + (size_t)(chunk - 16) * 16; const int c = g * 16 + kg * 4;
#pragma unroll
    for (int jout = 0; jout < 16; ++jout) { u32x2 w; w.x = cvt_pk_bf16(gelu_t(acc[jout][0]), gelu_t(acc[jout][1])); w.y = cvt_pk_bf16(gelu_t(acc[jout][2]), gelu_t(acc[jout][3]));
        *(u32x2*)(gy + (rowb + jout) * 512 + c) = w; }
    __syncthreads();
}

struct CRow { f32x4 g[3], v[3]; };
__device__ __forceinline__ f32x4 unpack4(unsigned x, unsigned y) { return (f32x4){bflo(x), bfhi(x), bflo(y), bfhi(y)}; }
__device__ __forceinline__ u32x4 conv_load(const bf16_t* p, int rowstride, int J, int rr) {
    u32x4 R = {0u, 0u, 0u, 0u};
    if (p != nullptr && rr >= 0 && rr < 128) { const size_t off = (size_t)rr * rowstride; const u32x2 g = *(const u32x2*)(p + off), v = *(const u32x2*)(p + off + J); R = (u32x4){g.x, g.y, v.x, v.y}; }
    return R;
}
__device__ __forceinline__ void conv_acc(f32x4& ag, f32x4& av, const CRow& R, const f32x4 (&wg)[9], const f32x4 (&wv)[9], int kh) {
#pragma unroll
    for (int k = 0; k < 3; ++k) { ag += wg[kh * 3 + k] * R.g[k]; av += wv[kh * 3 + k] * R.v[k]; }
}
#define CONV_STEP(FP, FC, FN, PUN, PLD, HUN, HLD, SLOT, r) do { if ((r) < rend) { \
        const int rl_ = ((r) + 4 <= rend) ? (r) + 4 : 1000; PLD = conv_load(pC, rowstride, J, rl_); HLD = conv_load(pH, rowstride, J, rl_); \
        xl[(SLOT) * 640 + (w + 1) * 64 + cgp] = PUN; if (pHslot >= 0) xl[(SLOT) * 640 + pHslot * 64 + cgp] = HUN; \
        if ((r) >= r0) { f32x4 ag = bg, av = bv; conv_acc(ag, av, FP, wg, wv, 0); conv_acc(ag, av, FC, wg, wv, 1); conv_acc(ag, av, FN, wg, wv, 2); \
            u32x2 w_; w_.x = cvt_pk_bf16(ag[0] * sigm(ag[0]) * av[0], ag[1] * sigm(ag[1]) * av[1]); w_.y = cvt_pk_bf16(ag[2] * sigm(ag[2]) * av[2], ag[3] * sigm(ag[3]) * av[3]); \
            *(u32x2*)(ap + (size_t)(r) * 64 * FFH) = w_; } \
        asm volatile("s_waitcnt lgkmcnt(0)" ::: "memory"); __builtin_amdgcn_s_barrier(); asm volatile("" ::: "memory"); \
        { const u32x4 nl_ = xl[(SLOT) * 640 + w * 64 + cgp], nr_ = xl[(SLOT) * 640 + (w + 2) * 64 + cgp]; const u32x4 own_ = PUN; \
          FP.g[0] = unpack4(nl_.x, nl_.y); FP.v[0] = unpack4(nl_.z, nl_.w); FP.g[1] = unpack4(own_.x, own_.y); FP.v[1] = unpack4(own_.z, own_.w); FP.g[2] = unpack4(nr_.x, nr_.y); FP.v[2] = unpack4(nr_.z, nr_.w); } } } while (0)
__device__ __forceinline__ void conv_phase(const bf16_t* up, int J, int j0, const float* convw, const float* convb, bf16_t* act, LAS unsigned char* lds, int bid, int G, int tid) {
    const int ldu = 2 * J, nslab = J / 256, nitems = 4 * 8 * 8 * nslab, rowstride = 64 * ldu;
    LAS u32x4* xl = (LAS u32x4*)lds;
    const int cgp = tid & 63, w = tid >> 6;
    for (int it = bid; it < nitems; it += G) {
        const int slab = it % nslab; int t = it / nslab; const int cg8 = t & 7; t >>= 3; const int band = t & 7, b = t >> 3;
        const int col = cg8 * 8 + w, jg = slab * 256 + cgp * 4;
        f32x4 wg[9], wv[9];
#pragma unroll
        for (int k = 0; k < 9; ++k) { wg[k] = *(const f32x4*)(convw + k * F2 + j0 + jg); wv[k] = *(const f32x4*)(convw + k * F2 + FFH + j0 + jg); }
        const f32x4 bg = *(const f32x4*)(convb + j0 + jg), bv = *(const f32x4*)(convb + FFH + j0 + jg);
        const bf16_t* pC = up + ((size_t)b * SEQ + col) * ldu + jg;
        const int pHslot = (w == 0) ? 0 : ((w == 7) ? 9 : -1);
        const bf16_t* pH = (w == 0) ? (col > 0 ? pC - ldu : nullptr) : ((w == 7) ? (col < 63 ? pC + ldu : nullptr) : nullptr);
        bf16_t* ap = act + ((size_t)b * SEQ + col) * FFH + j0 + jg;
        const int r0 = band * 16, rend = r0 + 16;
        CRow F0, F1, F2; u32x4 P0, P1, P2, H0, H1, H2;
#pragma unroll
        for (int k = 0; k < 3; ++k) { F0.g[k] = F0.v[k] = F1.g[k] = F1.v[k] = F2.g[k] = F2.v[k] = (f32x4){0.f, 0.f, 0.f, 0.f}; }
        P0 = conv_load(pC, rowstride, J, r0 - 1); H0 = conv_load(pH, rowstride, J, r0 - 1); P1 = conv_load(pC, rowstride, J, r0); H1 = conv_load(pH, rowstride, J, r0); P2 = P1; H2 = H1;
        __syncthreads();
        for (int r = r0 - 3; r < rend; r += 3) {
            CONV_STEP(F0, F1, F2, P0, P2, H0, H2, 0, r);
            CONV_STEP(F1, F2, F0, P1, P0, H1, H0, 1, r + 1);
            CONV_STEP(F2, F0, F1, P2, P1, H2, H1, 2, r + 2);
        }
    }
    __syncthreads();
}

#define XB_TMO      128
#define XB_XCNT(j)  (256  + 64 * (j))
#define XB_XSUB(j)  (1280 + 64 * (j))
#define XB_XGEN(j)  (2304 + 64 * (j))
#define XB_TOP      3328
#define XB_TOPGEN   3392
#define XCD_BAR_WORDS 3456
#define XB_SPIN_CAP (1u << 18)
__device__ __forceinline__ unsigned xb_ld(unsigned* p)              { return __hip_atomic_load(p, __ATOMIC_RELAXED, __HIP_MEMORY_SCOPE_AGENT); }
__device__ __forceinline__ unsigned xb_add(unsigned* p, unsigned v) { return __hip_atomic_fetch_add(p, v, __ATOMIC_RELAXED, __HIP_MEMORY_SCOPE_AGENT); }
__device__ __forceinline__ unsigned xb_xcc_id() { return (unsigned)__builtin_amdgcn_s_getreg((3 << 11) | 20) & 0xFu; }
#define XB_SPIN(cond, bar) do { unsigned _sp = 0; while (cond) { __builtin_amdgcn_s_sleep(1); \
    if ((++_sp & 255u) == 0u) { if (xb_ld(&(bar)[XB_TMO])) break; if (_sp > XB_SPIN_CAP) { atomicAdd(&(bar)[XB_TMO], 1u); break; } } } } while (0)
struct XcdBarrier { unsigned* bar; unsigned x; volatile LAS unsigned* st; };
__device__ __forceinline__ XcdBarrier xcd_barrier_post(unsigned* bar, volatile LAS unsigned* st) {
    XcdBarrier b; b.bar = bar; b.x = xb_xcc_id(); b.st = st;
    if (threadIdx.x == 0) (void)xb_add(&bar[XB_XCNT(b.x)], 1u);
    return b;
}
__device__ __forceinline__ void xcd_barrier_complete(unsigned* bar, unsigned x, unsigned& nloc, unsigned& nx) {
    const unsigned G = gridDim.x * gridDim.y * gridDim.z;
    unsigned sum, cnt, mine, sp = 0u;
    for (;;) {
        sum = 0u; cnt = 0u; mine = 0u;
#pragma unroll
        for (unsigned j = 0; j < 16; ++j) { const unsigned c = xb_ld(&bar[XB_XCNT(j)]); sum += c; cnt += (c > 0u) ? 1u : 0u; mine = (j == x) ? c : mine; }
        if (sum == G) break;
        __builtin_amdgcn_s_sleep(1);
        if ((++sp & 255u) == 0u) { if (xb_ld(&bar[XB_TMO])) break; if (sp > XB_SPIN_CAP) { atomicAdd(&bar[XB_TMO], 1u); break; } }
    }
    nloc = mine > 0u ? mine : 1u; nx = cnt > 0u ? cnt : 1u;
}
__device__ __forceinline__ void xcd_barrier(const XcdBarrier& b) {
    asm volatile("s_waitcnt vmcnt(0)" ::: "memory");
    __syncthreads();
    if (threadIdx.x == 0) {
        unsigned* bar = b.bar;
        __builtin_amdgcn_s_waitcnt(0);
        unsigned nloc = b.st[0], nx = b.st[1];
        if (nloc == 0u) { xcd_barrier_complete(bar, b.x, nloc, nx); b.st[0] = nloc; b.st[1] = nx; }
        const unsigned old = xb_add(&bar[XB_XSUB(b.x)], 1u);
        const unsigned gen = old / nloc;
        if (old + 1u == (gen + 1u) * nloc) {
            __builtin_amdgcn_fence(__ATOMIC_RELEASE, "agent");
            asm volatile("s_waitcnt vmcnt(0)" ::: "memory");
            const unsigned og = xb_add(&bar[XB_TOP], 1u);
            const unsigned tg = og / nx;
            if (og + 1u == (tg + 1u) * nx) xb_add(&bar[XB_TOPGEN], 1u);
            else XB_SPIN(xb_ld(&bar[XB_TOPGEN]) == tg, bar);
            __builtin_amdgcn_fence(__ATOMIC_ACQUIRE, "agent");
            xb_add(&bar[XB_XGEN(b.x)], 1u);
            asm volatile("s_waitcnt vmcnt(0)" ::: "memory");
        } else {
            XB_SPIN(xb_ld(&bar[XB_XGEN(b.x)]) == gen, bar);
            __builtin_amdgcn_fence(__ATOMIC_ACQUIRE, "agent");
            asm volatile("s_waitcnt vmcnt(0)" ::: "memory");
        }
    }
    __syncthreads();
}

constexpr int NPHASE = 15;
struct Args { const float* in[32]; float* out; unsigned char* ws; int ph_lo, ph_hi; };

__global__ void __launch_bounds__(NTHR, 2) fwd_kernel(Args a) {
    extern __shared__ __attribute__((aligned(16))) unsigned char lds_raw[];
    LAS unsigned char* lds = (LAS unsigned char*)lds_raw;
    cg::grid_group grid = cg::this_grid();
    const int tid = threadIdx.x, lane = tid & 63, wave = __builtin_amdgcn_readfirstlane(tid >> 6);
    const int G = gridDim.x, bid = blockIdx.x, gw = bid * 8 + wave, NGW = G * 8;
    unsigned char* ws = a.ws;
    const int lo = a.ph_lo, hi = a.ph_hi;
#define IN(k) (lo <= (k) && (k) < hi)
#ifndef PHMASK
#define PHMASK 0x7fff
#endif
#define PHON(k) ((PHMASK >> (k)) & 1)
#ifndef REPMASK
#define REPMASK 0
#endif
#define NREP(k) (1 + ((REPMASK >> (k)) & 1))
#define SEAM(k) do { if (IN(k) && IN((k) + 1)) xcd_barrier(xbar); } while (0)
    if (tid < 16) ((LAS unsigned*)(lds + LDS_BYTES - 64))[tid] = 0u;
    __syncthreads();
    if (a.ph_lo < 0) grid.sync();
    const XcdBarrier xbar = xcd_barrier_post((unsigned*)(ws + WS_BAR), (volatile LAS unsigned*)(lds + LDS_BYTES - 64));
#define DUMPG(k) do { } while (0)
#if defined(DBG_TS)
    unsigned long long ts_a = 0, ts_b = 0;
    if (DBG_TS == 0) ts_a = __builtin_amdgcn_s_memrealtime();
#define TSTAMP(k) do { if ((k) + 1 == DBG_TS || ((k) == 2 && DBG_TS == 103)) ts_a = __builtin_amdgcn_s_memrealtime(); if ((k) == DBG_TS) ts_b = __builtin_amdgcn_s_memrealtime(); } while (0)
#elif defined(DBG_TSEAM)
    unsigned long long ts_a = 0, ts_b = 0;
#define TSTAMP(k) do { if ((k) == DBG_TSEAM) ts_b = __builtin_amdgcn_s_memrealtime(); } while (0)
#define TSPRE(k) do { if ((k) == DBG_TSEAM) ts_a = __builtin_amdgcn_s_memrealtime(); } while (0)
#else
#define TSTAMP(k) do { } while (0)
#endif
#ifndef TSPRE
#define TSPRE(k) do { } while (0)
#endif
    float* mod = (float*)(ws + WS_MOD);
    bf16_t* hbuf = (bf16_t*)(ws + WS_HBUF);
    using pg8::Gemm; using pg8::gemm_phase;

    P0Args A;
    { A.c = a.in[1]; A.cctx = a.in[3]; A.wada = a.in[4]; A.bada = a.in[5]; A.w_in = a.in[7]; A.w_glu = a.in[16]; A.w_pa = a.in[22]; A.w_pb = a.in[23]; A.w_out = a.in[25];
        A.w_up = a.in[27]; A.w_down = a.in[30]; A.sgu_w = a.in[20]; A.a_re = a.in[8]; A.a_im = a.in[9]; A.logstep = a.in[10]; A.b_re = a.in[11]; A.b_im = a.in[12]; A.c_re = a.in[13]; A.c_im = a.in[14]; A.dskip = a.in[15]; }
    if (PHON(0) && IN(0)) for (int _r = 0; _r < NREP(0); ++_r) {
        for (int it = bid; it < 96 + 64; it += G) {
            if (it < 96) p0_gemv_item(it, A, mod, lds, tid, lane, wave);
            else p0_s5_item(it - 96, A, (bf16_t*)(ws + WS_PFRAG), (bf16_t*)(ws + WS_QFRAG), (bf16_t*)(ws + WS_TFRAG), lds, tid);
        }
        __syncthreads();
        LAS float* scr = (LAS float*)(lds + wave * 16384);
        constexpr int NIT = 1792 + 128 + 256 + 256 + 512 + 2816 + 1408 + 256;
        const bool trall = G < 224;
        for (int it = trall ? gw : (bid - 160) * 8 + wave; it < NIT && (trall || bid >= 160); it += trall ? NGW : (G - 160) * 8) { int r = it;
            if (tr_job(r, A.w_in, 3584, 0, 0, 1024, 3584, (bf16_t*)(ws + WS_WIN), 1024, 0, scr, lane)) continue;
            if (tr_job(r, A.w_glu, 512, 0, 0, 512, 512, (bf16_t*)(ws + WS_WGLU), 512, 0, scr, lane)) continue;
            if (tr_job(r, A.w_pa, 1024, 0, 0, 512, 1024, (bf16_t*)(ws + WS_WPA), 1024, 0, scr, lane, 0)) continue;
            if (tr_job(r, A.w_pb, 1024, 0, 0, 512, 1024, (bf16_t*)(ws + WS_WPA), 1024, 0, scr, lane, 512)) continue;
            if (tr_job(r, A.w_out, 1024, 0, 0, 1024, 1024, (bf16_t*)(ws + WS_WOUT), 1024, 0, scr, lane)) continue;
            if (tr_job(r, A.w_up, F2, 0, 0, 1024, J1, (bf16_t*)(ws + WS_WUP1), 1024, 0, scr, lane)) continue;
            if (tr_job(r, A.w_up, F2, 0, FFH, 1024, J1, (bf16_t*)(ws + WS_WUP1), 1024, J1, scr, lane)) continue;
            if (tr_job(r, A.w_up, F2, 0, J1, 1024, J2, (bf16_t*)(ws + WS_WUP2), 1024, 0, scr, lane)) continue;
            if (tr_job(r, A.w_up, F2, 0, FFH + J1, 1024, J2, (bf16_t*)(ws + WS_WUP2), 1024, J2, scr, lane)) continue;
            if (tr_job(r, A.w_down, 1024, 0, 0, FFH, 1024, (bf16_t*)(ws + WS_WDN1), FFH, 0, scr, lane)) continue;
            { const size_t base = (size_t)r * 512 + lane * 8; const f32x4 v0 = *(const f32x4*)(A.sgu_w + base), v1 = *(const f32x4*)(A.sgu_w + base + 4);
              *(u32x4*)((bf16_t*)(ws + WS_SGUW) + base) = pack8(v0, v1); }
        }
    }
    TSPRE(0); SEAM(0); DUMPG(0); TSTAMP(0);
    if (PHON(1) && IN(1)) {
        mod_rows(a.in[0], a.in[2], MALL, a.in[6], mod, 0, 1024, hbuf, gw, NGW, lane);
    }
    TSPRE(1); SEAM(1); DUMPG(1); TSTAMP(1);
    if (PHON(2) && IN(2)) for (int _r = 0; _r < NREP(2); ++_r) {
        Gemm g{hbuf, (const bf16_t*)(ws + WS_WIN), MALL, 3584, 1024}; OrderX S; S.init(MTOK, 3584, G, bid);
        EpiIn E{(bf16_t*)(ws + WS_UG), (bf16_t*)(ws + WS_ZB), (bf16_t*)(ws + WS_GATES), a.in[24]};
        gemm_phase<EpiIn, OrderX, true, true>(lds, g, S, E);
    }
    TSPRE(2); SEAM(2); DUMPG(2); TSTAMP(2);
    if (PHON(3) && IN(3)) for (int _r = 0; _r < NREP(3); ++_r) {
#ifndef NOS5AB
        for (int it = bid; it < 256; it += G) s5ab_item((((it & 7) * 8 + ((it >> 3) & 7)) >> 5) * 128 + (it >> 6) * 32 + (((it & 7) * 8 + ((it >> 3) & 7)) & 31), lds, (const bf16_t*)(ws + WS_PFRAG), (const bf16_t*)(ws + WS_UG), hbuf, (const bf16_t*)(ws + WS_WIN), (bf16_t*)(ws + WS_HPREV), a.in[8], a.in[9], a.in[10], tid, lane, wave);
#endif
#if defined(DBG_TS)
        if (DBG_TS == 103) ts_b = __builtin_amdgcn_s_memrealtime();
#endif
#ifndef NOSGU
        for (int it = bid; it < 256; it += G) sgu_item(it, lds, (const bf16_t*)(ws + WS_ZB), (const bf16_t*)(ws + WS_SGUW), a.in[21], a.in[18], a.in[19], (bf16_t*)(ws + WS_YAB) + 512, tid, lane, wave);
#endif
    }
    TSPRE(3); SEAM(3); DUMPG(3); TSTAMP(3);
    if (PHON(4) && IN(4)) for (int _r = 0; _r < NREP(4); ++_r) {
        for (int it = bid; it < 512; it += G) s5c_item(((it >> 5) >> 2) * 128 + ((it & 7) * 4 + ((it >> 3) & 3)) * 4 + ((it >> 5) & 3), lds, (const bf16_t*)(ws + WS_QFRAG), (const bf16_t*)(ws + WS_TFRAG), (const bf16_t*)(ws + WS_UG), (const bf16_t*)(ws + WS_HPREV), (bf16_t*)(ws + WS_GY), tid, lane, wave);
    }
    TSPRE(4); SEAM(4); DUMPG(4); TSTAMP(4);
    if (PHON(5) && IN(5)) for (int _r = 0; _r < NREP(5); ++_r) {
        Gemm g{(const bf16_t*)(ws + WS_GY), (const bf16_t*)(ws + WS_WGLU), MTOK, 512, 512}; OrderX S; S.init(MTOK, 512, G, bid);
        EpiGlu E{(const bf16_t*)(ws + WS_GY), (bf16_t*)(ws + WS_YAB), a.in[17]};
        gemm_phase<EpiGlu, OrderX, true, true>(lds, g, S, E);
    }
    TSPRE(5); SEAM(5); DUMPG(5); TSTAMP(5);
    if (PHON(6) && IN(6)) for (int _r = 0; _r < NREP(6); ++_r) {
        Gemm g{(const bf16_t*)(ws + WS_YAB), (const bf16_t*)(ws + WS_WPA), MTOK, 1024, 1024}; OrderX S; S.init(MTOK, 1024, G, bid);
        EpiMerge E{(const bf16_t*)(ws + WS_GATES), (bf16_t*)(ws + WS_MBUF)};
        gemm_phase<EpiMerge, OrderX, true, true>(lds, g, S, E);
    }
    TSPRE(6); SEAM(6); DUMPG(6); TSTAMP(6);
    if (PHON(7) && IN(7)) for (int _r = 0; _r < NREP(7); ++_r) {
        Gemm g{(const bf16_t*)(ws + WS_MBUF), (const bf16_t*)(ws + WS_WOUT), MTOK, 1024, 1024}; OrderX S; S.init(MTOK, 1024, G, bid);
        EpiRes E{a.in[0], a.out, mod + 2048};
        gemm_phase<EpiRes, OrderX, true, true>(lds, g, S, E);
    }
    TSPRE(7); SEAM(7); DUMPG(7); TSTAMP(7);
    if (PHON(8) && IN(8)) for (int _r = 0; _r < NREP(8); ++_r) mod_rows2(a.out, nullptr, MTOK, a.in[26], mod, 3072, 4096, hbuf, gw, NGW, lane);
    TSPRE(8); SEAM(8); DUMPG(8); TSTAMP(8);
    if (PHON(9) && IN(9)) for (int _r = 0; _r < NREP(9); ++_r) {
        Gemm g{hbuf, (const bf16_t*)(ws + WS_WUP1), MTOK, 2 * J1, 1024}; OrderX S; S.init(MTOK, 2 * J1, G, bid);
        EpiPlain E{(bf16_t*)(ws + WS_UPB), 2 * J1};
        gemm_phase<EpiPlain, OrderX, true, true>(lds, g, S, E);
    }
#ifdef DBG_DUP9
    if (PHON(9) && IN(9)) {
        Gemm g{hbuf, (const bf16_t*)(ws + WS_WUP1), MTOK, 2 * J1, 1024}; OrderX S; S.init(MTOK, 2 * J1, G, bid);
        EpiPlain E{(bf16_t*)(ws + WS_UPB), 2 * J1};
        gemm_phase<EpiPlain, OrderX, true, true>(lds, g, S, E);
    }
#endif
    TSPRE(9); SEAM(9); DUMPG(9); TSTAMP(9);
    if (PHON(10) && IN(10)) for (int _r = 0; _r < NREP(10); ++_r) conv_phase((const bf16_t*)(ws + WS_UPB), J1, 0, a.in[28], a.in[29], (bf16_t*)(ws + WS_ACT1), lds, bid, G, tid);
    TSPRE(10); SEAM(10); DUMPG(10); TSTAMP(10);
    if (PHON(11) && IN(11)) for (int _r = 0; _r < NREP(11); ++_r) {
        Gemm g{hbuf, (const bf16_t*)(ws + WS_WUP2), MTOK, 2 * J2, 1024}; OrderX S; S.init(MTOK, 2 * J2, G, bid);
        EpiPlain E{(bf16_t*)(ws + WS_UPB), 2 * J2};
        gemm_phase<EpiPlain, OrderX, true, true>(lds, g, S, E);
    }
    TSPRE(11); SEAM(11); DUMPG(11); TSTAMP(11);
    if (PHON(12) && IN(12)) for (int _r = 0; _r < NREP(12); ++_r) conv_phase((const bf16_t*)(ws + WS_UPB), J2, J1, a.in[28], a.in[29], (bf16_t*)(ws + WS_ACT1), lds, bid, G, tid);
    TSPRE(12); SEAM(12); DUMPG(12); TSTAMP(12);
    if (PHON(13) && IN(13)) for (int _r = 0; _r < NREP(13); ++_r) {
        Gemm g{(const bf16_t*)(ws + WS_ACT1), (const bf16_t*)(ws + WS_WDN1), MTOK, 1024, FFH}; OrderX S; S.init(MTOK, 1024, G, bid);
        EpiRes E{a.out, a.out, mod + 5120};
        gemm_phase<EpiRes, OrderX, true, true>(lds, g, S, E);
    }
    TSPRE(13); SEAM(13); DUMPG(13); TSTAMP(13);
    if (PHON(14) && IN(14)) for (int _r = 0; _r < NREP(14); ++_r) {
        const float* gf = a.in[31];
        for (int m0 = gw; m0 < MTOK; m0 += 2 * NGW) { const int m1 = m0 + NGW;
            f32x4* xr0 = (f32x4*)(a.out + (size_t)m0 * DM); f32x4* xr1 = (f32x4*)(a.out + (size_t)(m1 < MTOK ? m1 : m0) * DM);
            f32x4 v[4], w[4]; float s0 = 0.f, s1 = 0.f;
#pragma unroll
            for (int j = 0; j < 4; ++j) { v[j] = xr0[lane + 64 * j]; w[j] = xr1[lane + 64 * j]; }
#pragma unroll
            for (int j = 0; j < 4; ++j) { s0 += (v[j][0] * v[j][0] + v[j][1] * v[j][1]) + (v[j][2] * v[j][2] + v[j][3] * v[j][3]); s1 += (w[j][0] * w[j][0] + w[j][1] * w[j][1]) + (w[j][2] * w[j][2] + w[j][3] * w[j][3]); }
            const float rstd0 = rsqrtf(wave_sum(s0) * (1.f / DM) + EPS), rstd1 = rsqrtf(wave_sum(s1) * (1.f / DM) + EPS);
#pragma unroll
            for (int j = 0; j < 4; ++j) { const f32x4 g4 = ((const f32x4*)gf)[lane + 64 * j]; xr0[lane + 64 * j] = (v[j] * rstd0) * g4; if (m1 < MTOK) xr1[lane + 64 * j] = (w[j] * rstd1) * g4; } }
    }
#if defined(DBG_TS) || defined(DBG_TSEAM)
    TSTAMP(14);
    if (bid == 0 && tid == 0) { asm volatile("s_waitcnt vmcnt(0)" ::: "memory"); float tq = (float)(ts_b - ts_a) * 0.01f; a.out[0] += tq * 0.004f; }
#endif
#undef IN
#undef SEAM
}

#ifndef MK_SPLIT
#define MK_SPLIT 0
#endif
extern "C" void kernel_launch(void* const* d_in, const int* in_sizes, int n_in, void* d_out, int out_size, void* d_ws, size_t ws_size, hipStream_t stream) {
    static int grid = 0;
    if (grid == 0) {
        if (n_in != 32 || out_size != MTOK * DM || ws_size < WS_END) { fprintf(stderr, "kernel_launch: unexpected shapes (n_in %d out %d ws %zu)\n", n_in, out_size, ws_size); grid = -1; return; }
        int dev = 0, cus = 0, per_cu = 0;
        hipGetDevice(&dev); hipDeviceGetAttribute(&cus, hipDeviceAttributeMultiprocessorCount, dev);
        if (hipFuncSetAttribute((const void*)fwd_kernel, hipFuncAttributeMaxDynamicSharedMemorySize, LDS_BYTES) != hipSuccess) { fprintf(stderr, "kernel_launch: hipFuncSetAttribute failed\n"); grid = -1; return; }
        if (hipOccupancyMaxActiveBlocksPerMultiprocessor(&per_cu, (const void*)fwd_kernel, NTHR, LDS_BYTES) != hipSuccess || per_cu < 1) { fprintf(stderr, "kernel_launch: occupancy query gave %d\n", per_cu); per_cu = 1; }
        (void)hipGetLastError();
        grid = cus * per_cu;
    }
    if (grid < 0) return;
    if (hipMemsetAsync((char*)d_ws + WS_BAR, 0, 16384, stream) != hipSuccess) { fprintf(stderr, "kernel_launch: memset failed\n"); return; }
    Args a{};
    for (int i = 0; i < 32; ++i) a.in[i] = (const float*)d_in[i];
    a.out = (float*)d_out; a.ws = (unsigned char*)d_ws;
#if MK_SPLIT
    for (int p = 0; p < NPHASE; ++p) { a.ph_lo = p; a.ph_hi = p + 1; hipLaunchKernelGGL(fwd_kernel, dim3(grid), dim3(NTHR), LDS_BYTES, stream, a); }
#else
    a.ph_lo = 0; a.ph_hi = NPHASE;
    void* args[] = {&a};
    hipError_t e = hipLaunchCooperativeKernel((const void*)fwd_kernel, dim3(grid), dim3(NTHR), args, LDS_BYTES, stream);
    if (e != hipSuccess) fprintf(stderr, "kernel_launch: cooperative launch failed: %s (grid %d)\n", hipGetErrorString(e), grid);
#endif
}
```
